# Optimizing an MI355X kernel written in HIP

```python
import math
import jax, jax.numpy as jnp
from jax import lax
import numpy as np

D_MODEL = 2048
BATCH = 2
SEQ = 16384
DEPTH = 2

CHUNK = 64
D_CONV = 1024
CONV_K = 3
N_HEADS = 8
HEAD_DIM = 128
D_ATTN = N_HEADS * HEAD_DIM
Q_BLOCK = 128
N_BRANCH = 2
P_TOTAL = 3 * D_CONV + 3 * D_ATTN + N_HEADS + N_BRANCH * D_MODEL
D_FF = 5632
N_EXPERTS = 8
TOP_K = 2
D_FF_EXPERT = 7168
MOE_GROUP = 256
N_DENSE = (DEPTH + 1) // 2
N_MOE = DEPTH // 2
RMS_EPS = 1e-6

kernel_name = "hybrid_conv_forgetting_attn_moe_trunk"


def rmsnorm(x, g):
    xf = x.astype(jnp.float32)
    y = xf * lax.rsqrt(jnp.mean(xf * xf, axis=-1, keepdims=True) + RMS_EPS)
    return (y * g.astype(jnp.float32)).astype(x.dtype)


def causal_dwconv(u, w):
    S = u.shape[1]
    up = jnp.pad(u, ((0, 0), (CONV_K - 1, 0), (0, 0)))
    y = up[:, 0:S] * w[0]
    for j in range(1, CONV_K):
        y = y + up[:, j:j + S] * w[j]
    return y


def forgetting_attention(q, k, v, log_f):
    Bsz, S, H, Dh = q.shape
    nb = S // Q_BLOCK
    scale = 1.0 / math.sqrt(Dh)
    c = jnp.cumsum(log_f, axis=1)
    qb = q.reshape(Bsz, nb, Q_BLOCK, H, Dh).transpose(1, 0, 3, 2, 4)
    cq = c.reshape(Bsz, nb, Q_BLOCK, H).transpose(1, 0, 3, 2)
    kT = k.transpose(0, 2, 1, 3)
    vT = v.transpose(0, 2, 1, 3)
    ck = c.transpose(0, 2, 1)
    key_pos = jnp.arange(S)

    def block(args):
        qi, cqi, bi = args
        s = jnp.einsum('bhqd,bhkd->bhqk', qi, kT, preferred_element_type=jnp.float32) * scale
        s = s + cqi[..., None] - ck[:, :, None, :]
        q_pos = bi * Q_BLOCK + jnp.arange(Q_BLOCK)
        mask = key_pos[None, :] <= q_pos[:, None]
        s = jnp.where(mask[None, None], s, -jnp.inf)
        p = jax.nn.softmax(s, axis=-1)
        return jnp.einsum('bhqk,bhkd->bhqd', p.astype(vT.dtype), vT)

    o = lax.map(block, (qb, cq, jnp.arange(nb)))
    return o.transpose(1, 0, 3, 2, 4).reshape(Bsz, S, H * Dh)


def hybrid_mixer(a, w_in, b_forget, conv_w, w_conv_out, w_attn_out, w_o):
    Bsz, S, _ = a.shape
    proj = a @ w_in
    sizes = [D_CONV, D_CONV, D_CONV, D_ATTN, D_ATTN, D_ATTN, N_HEADS]
    offs = [int(o) for o in np.cumsum(sizes)]
    b_gate, c_gate, u, q, k, v, f_logit, gates = jnp.split(proj, offs, axis=-1)
    y_conv = (b_gate * causal_dwconv(c_gate * u, conv_w)) @ w_conv_out
    log_f = jax.nn.log_sigmoid(f_logit.astype(jnp.float32) + b_forget.astype(jnp.float32))
    o = forgetting_attention(q.reshape(Bsz, S, N_HEADS, HEAD_DIM),
                             k.reshape(Bsz, S, N_HEADS, HEAD_DIM),
                             v.reshape(Bsz, S, N_HEADS, HEAD_DIM), log_f)
    y_attn = o @ w_attn_out
    g = jax.nn.sigmoid(gates)
    g_conv, g_attn = g[..., :D_MODEL], g[..., D_MODEL:]
    return (g_conv * y_conv + g_attn * y_attn) @ w_o


def swiglu(a, w_gate, w_up, w_down):
    return (jax.nn.silu(a @ w_gate) * (a @ w_up)) @ w_down


def moe_swiglu(a, router_w, router_b, w_gate, w_up, w_down):
    Bsz, S, D = a.shape
    af = a.reshape(-1, D)
    N = af.shape[0]
    logits = (af @ router_w).astype(jnp.float32) + router_b.astype(jnp.float32)
    top_logit, top_idx = lax.top_k(logits, TOP_K)
    top_w = jax.nn.softmax(top_logit, axis=-1)
    NK = N * TOP_K
    flat_e = top_idx.reshape(NK).astype(jnp.int32)
    slot = jnp.arange(NK, dtype=jnp.int32)
    se, order = lax.sort((flat_e, slot), num_keys=1, is_stable=True)
    stok = order // TOP_K
    sw = top_w.reshape(NK)[order]
    counts = jnp.bincount(flat_e, length=N_EXPERTS)
    padded = (counts + MOE_GROUP - 1) // MOE_GROUP * MOE_GROUP
    pad_end = jnp.cumsum(padded)
    pad_start = pad_end - padded
    start = jnp.cumsum(counts) - counts
    dest = pad_start[se] + slot - start[se]
    n_blocks = -(-NK // MOE_GROUP) + N_EXPERTS
    R = n_blocks * MOE_GROUP
    row_tok = jnp.zeros((R,), jnp.int32).at[dest].set(stok)
    row_w = jnp.zeros((R,), jnp.float32).at[dest].set(sw)
    block_start = jnp.arange(n_blocks) * MOE_GROUP
    block_e = jnp.minimum(jnp.searchsorted(pad_end, block_start, side='right'), N_EXPERTS - 1)
    xb = af[row_tok].reshape(n_blocks, MOE_GROUP, D)

    def expert_block(args):
        xg, e = args
        hdn = jax.nn.silu(xg @ w_gate[e]) * (xg @ w_up[e])
        return hdn @ w_down[e]

    yb = lax.map(expert_block, (xb, block_e)).reshape(R, D)
    y = jax.ops.segment_sum(yb.astype(jnp.float32) * row_w[:, None], row_tok, num_segments=N)
    return y.astype(a.dtype).reshape(Bsz, S, D)


def setup_inputs(seed: int = 0) -> dict:
    key = jax.random.key(seed)
    ks = jax.random.split(key, 20)
    f32 = jnp.float32

    def nrm(k, shape, fan_in):
        return jax.random.normal(k, shape, f32) * (fan_in ** -0.5)

    return {
        "x": jax.random.normal(ks[0], (BATCH, SEQ, D_MODEL), f32),
        "mix_norm": 1.0 + 0.02 * jax.random.normal(ks[1], (DEPTH, D_MODEL), f32),
        "w_in": nrm(ks[2], (DEPTH, D_MODEL, P_TOTAL), D_MODEL),
        "b_forget": 4.0 + 0.5 * jax.random.normal(ks[3], (DEPTH, N_HEADS), f32),
        "conv_w": nrm(ks[4], (DEPTH, CONV_K, D_CONV), CONV_K),
        "w_conv_out": nrm(ks[5], (DEPTH, D_CONV, D_MODEL), D_CONV),
        "w_attn_out": nrm(ks[6], (DEPTH, D_ATTN, D_MODEL), D_ATTN),
        "w_o": nrm(ks[7], (DEPTH, D_MODEL, D_MODEL), D_MODEL),
        "ffn_norm": 1.0 + 0.02 * jax.random.normal(ks[8], (DEPTH, D_MODEL), f32),
        "dense_w_gate": nrm(ks[9], (N_DENSE, D_MODEL, D_FF), D_MODEL),
        "dense_w_up": nrm(ks[10], (N_DENSE, D_MODEL, D_FF), D_MODEL),
        "dense_w_down": nrm(ks[11], (N_DENSE, D_FF, D_MODEL), D_FF),
        "router_w": nrm(ks[12], (N_MOE, D_MODEL, N_EXPERTS), D_MODEL),
        "router_b": 0.01 * jax.random.normal(ks[13], (N_MOE, N_EXPERTS), f32),
        "moe_w_gate": nrm(ks[14], (N_MOE, N_EXPERTS, D_MODEL, D_FF_EXPERT), D_MODEL),
        "moe_w_up": nrm(ks[15], (N_MOE, N_EXPERTS, D_MODEL, D_FF_EXPERT), D_MODEL),
        "moe_w_down": nrm(ks[16], (N_MOE, N_EXPERTS, D_FF_EXPERT, D_MODEL), D_FF_EXPERT),
        "final_norm": 1.0 + 0.02 * jax.random.normal(ks[17], (D_MODEL,), f32),
    }


def reference(x, mix_norm, w_in, b_forget, conv_w, w_conv_out, w_attn_out, w_o, ffn_norm,
              dense_w_gate, dense_w_up, dense_w_down, router_w, router_b,
              moe_w_gate, moe_w_up, moe_w_down, final_norm):
    h = x
    for layer in range(DEPTH):
        a = rmsnorm(h, mix_norm[layer])
        h = h + hybrid_mixer(a, w_in[layer], b_forget[layer], conv_w[layer],
                             w_conv_out[layer], w_attn_out[layer], w_o[layer])
        a = rmsnorm(h, ffn_norm[layer])
        if layer % 2 == 0:
            i = layer // 2
            h = h + swiglu(a, dense_w_gate[i], dense_w_up[i], dense_w_down[i])
        else:
            i = layer // 2
            h = h + moe_swiglu(a, router_w[i], router_b[i], moe_w_gate[i], moe_w_up[i], moe_w_down[i])
    return rmsnorm(h, final_norm)
```

```cpp
#include <hip/hip_runtime.h>
#include <cstdio>
#include <cstdint>
#include <cstring>
namespace pg8 {
#define PG8_LAS __attribute__((address_space(3)))
typedef unsigned short bf16_t;
typedef short bf16x8 __attribute__((ext_vector_type(8)));
typedef float f32x4 __attribute__((ext_vector_type(4)));
typedef unsigned u32x4 __attribute__((ext_vector_type(4)));
constexpr int BM = 256, BK = 64, HALF = 128, HTB = HALF * BK * 2  , STAGE_BYTES = 8 * HTB, NXCD = 8, WGM = 8;

__host__ __device__ __forceinline__ int lds_byte(int r, int c) { const int st = (r >> 4) * 2 + (c >> 5), rr = r & 15, cc = c & 31, ob = rr * 64 + cc * 2; return st * 1024 + (ob ^ (((ob >> 9) & 1) << 5)); }
__host__ __device__ __forceinline__ void stage_rc(int b, int& R, int& C) { const int st = b / 1024, sb = b % 1024, swz = sb ^ (((sb >> 9) & 1) << 5); R = (st >> 1) * 16 + swz / 64; C = (st & 1) * 32 + (swz % 64) / 2; }
__host__ __device__ __forceinline__ int perm32(int rho) { const int n = rho >> 4, i = rho & 15; return 8 * (i >> 2) + 4 * n + (i & 3); }

__device__ __forceinline__ int opaque_tid() { int t = (int)threadIdx.x; asm volatile("" : "+v"(t)); return t; }
struct Unit { int pm, pn; };
struct Gemm { const bf16_t* A; const bf16_t* Bt; int M, N, K; };

struct StaticOrder {
    int nM, nN, nwg, G, c;
    __host__ __device__ void init(int M, int N, int G_, int c_) { nM = M / BM; nN = N / BM; nwg = nM * nN; G = G_; c = c_; }
    __host__ __device__ bool next(int i, Unit& u) const {
        const long L = (long)i * G + c; if (L >= nwg) return false;
        int wgid = (int)L; { const int q = nwg / NXCD, r = nwg % NXCD, xcd = wgid % NXCD, off = wgid / NXCD; wgid = (xcd < r ? xcd * (q + 1) : r * (q + 1) + (xcd - r) * q) + off; }
        const int nig = WGM * nN, gid = wgid / nig, fm = gid * WGM, gsz = (nM - fm) < WGM ? (nM - fm) : WGM;
        u.pm = fm + ((wgid % nig) % gsz); u.pn = (wgid % nig) / gsz; return true;
    }
    __device__ __forceinline__ void a_ready(const Unit&) const {}
    __device__ __forceinline__ void done(const Unit&) const {}
    __device__ __forceinline__ const char* bbase(const Gemm& g, const Unit&) const { return (const char*)g.Bt; }
};
__device__ __forceinline__ unsigned cvt_pk_bf16(float lo, float hi) { unsigned r; asm volatile("v_cvt_pk_bf16_f32 %0, %1, %2" : "=v"(r) : "v"(lo), "v"(hi)); return r; }
typedef float f32x2 __attribute__((ext_vector_type(2)));
__device__ __forceinline__ float sigm(float x) { return __builtin_amdgcn_rcpf(1.0f + __builtin_amdgcn_exp2f(-1.4426950408889634f * x)); }
__device__ __forceinline__ float bf_lo(unsigned w) { return __uint_as_float(w << 16); }
__device__ __forceinline__ float bf_hi(unsigned w) { return __uint_as_float(w & 0xffff0000u); }

struct EpiInProj {
    static constexpr bool PERM = true, AFTER_DRAIN = false;
    bf16_t* P6; bf16_t* Gt; int M;
    __device__ __forceinline__ void operator()(const f32x4 (&acc)[2][2][4][2], const Unit& u, int wr, int wc, int fr, int fq) const {
        const int row0 = u.pm * BM + wr * 64 + fr; const int colt = u.pn * BM; const int t = colt >> 10; const bool gate = t >= 6;
        bf16_t* base = gate ? Gt + (colt - 6144) : P6 + (size_t)t * M * 1024 + (colt & 1023);
        const int ldc = gate ? 4096 : 1024; const int col0 = wc * 32 + 8 * fq;
#pragma unroll
        for (int ai = 0; ai < 2; ++ai)
#pragma unroll
            for (int m = 0; m < 4; ++m) { bf16_t* rowp = base + (size_t)(row0 + ai * HALF + m * 16) * ldc + col0;
#pragma unroll
                for (int bj = 0; bj < 2; ++bj) { f32x4 v0 = acc[ai][bj][m][0], v1 = acc[ai][bj][m][1];
                    if (gate) {
#pragma unroll
                        for (int j = 0; j < 4; ++j) { v0[j] = sigm(v0[j]); v1[j] = sigm(v1[j]); } }
                    u32x4 w; w.x = cvt_pk_bf16(v0[0], v0[1]); w.y = cvt_pk_bf16(v0[2], v0[3]); w.z = cvt_pk_bf16(v1[0], v1[1]); w.w = cvt_pk_bf16(v1[2], v1[3]);
                    *(u32x4*)(rowp + bj * HALF) = w; } }
    }
};
template <int MODE> struct EpiMerge {
    static constexpr bool PERM = true, AFTER_DRAIN = false;
    const bf16_t* Gt; bf16_t* Mb;
    __device__ __forceinline__ void operator()(const f32x4 (&acc)[2][2][4][2], const Unit& u, int wr, int wc, int fr, int fq) const {
        const int row0 = u.pm * BM + wr * 64 + fr; const int col0 = u.pn * BM + wc * 32 + 8 * fq;
#pragma unroll
        for (int ai = 0; ai < 2; ++ai)
#pragma unroll
            for (int m = 0; m < 4; ++m) { const size_t r = (size_t)(row0 + ai * HALF + m * 16); const bf16_t* gp = Gt + r * 4096 + col0; bf16_t* mp = Mb + r * 2048 + col0;
#pragma unroll
                for (int bj = 0; bj < 2; ++bj) { const u32x4 gw = *(const u32x4*)(gp + bj * HALF); const f32x4 a0 = acc[ai][bj][m][0], a1 = acc[ai][bj][m][1];
                    f32x4 v0, v1;
                    v0[0] = bf_lo(gw.x) * a0[0]; v0[1] = bf_hi(gw.x) * a0[1]; v0[2] = bf_lo(gw.y) * a0[2]; v0[3] = bf_hi(gw.y) * a0[3];
                    v1[0] = bf_lo(gw.z) * a1[0]; v1[1] = bf_hi(gw.z) * a1[1]; v1[2] = bf_lo(gw.w) * a1[2]; v1[3] = bf_hi(gw.w) * a1[3];
                    if (MODE == 1) { const u32x4 mw = *(const u32x4*)(mp + bj * HALF);
                        v0[0] += bf_lo(mw.x); v0[1] += bf_hi(mw.x); v0[2] += bf_lo(mw.y); v0[3] += bf_hi(mw.y);
                        v1[0] += bf_lo(mw.z); v1[1] += bf_hi(mw.z); v1[2] += bf_lo(mw.w); v1[3] += bf_hi(mw.w); }
                    u32x4 w; w.x = cvt_pk_bf16(v0[0], v0[1]); w.y = cvt_pk_bf16(v0[2], v0[3]); w.z = cvt_pk_bf16(v1[0], v1[1]); w.w = cvt_pk_bf16(v1[2], v1[3]);
                    *(u32x4*)(mp + bj * HALF) = w; } }
    }
};
struct EpiResid {
    static constexpr bool PERM = false, AFTER_DRAIN = false;
    const float* base; float* out;
    __device__ __forceinline__ void operator()(const f32x4 (&acc)[2][2][4][2], const Unit& u, int wr, int wc, int fr, int fq) const {
        const int row0 = u.pm * BM + wr * 64 + fr, col0 = u.pn * BM + wc * 32 + 4 * fq;
#pragma unroll
        for (int ai = 0; ai < 2; ++ai)
#pragma unroll
            for (int m = 0; m < 4; ++m) { const size_t off = (size_t)(row0 + ai * HALF + m * 16) * 2048 + col0;
#pragma unroll
                for (int bj = 0; bj < 2; ++bj)
#pragma unroll
                    for (int n = 0; n < 2; ++n) { const f32x4 bs = *(const f32x4*)(base + off + bj * HALF + n * 16); *(f32x4*)(out + off + bj * HALF + n * 16) = bs + acc[ai][bj][m][n]; }
                asm volatile("" ::: "memory"); }
    }
};
struct EpiSwiGLU {
    static constexpr bool PERM = true, AFTER_DRAIN = false;
    bf16_t* H; int ldh;
    __device__ __forceinline__ void operator()(const f32x4 (&acc)[2][2][4][2], const Unit& u, int wr, int wc, int fr, int fq) const {
        const int row0 = u.pm * BM + wr * 64 + fr; const int col0 = u.pn * HALF + wc * 32 + 8 * fq;
#pragma unroll
        for (int ai = 0; ai < 2; ++ai)
#pragma unroll
            for (int m = 0; m < 4; ++m) { bf16_t* rowp = H + (size_t)(row0 + ai * HALF + m * 16) * ldh + col0;
                const f32x4 g0 = acc[ai][0][m][0], g1 = acc[ai][0][m][1], u0 = acc[ai][1][m][0], u1 = acc[ai][1][m][1]; f32x4 v0, v1;
#pragma unroll
                for (int j = 0; j < 4; ++j) { v0[j] = g0[j] * sigm(g0[j]) * u0[j]; v1[j] = g1[j] * sigm(g1[j]) * u1[j]; }
                u32x4 w; w.x = cvt_pk_bf16(v0[0], v0[1]); w.y = cvt_pk_bf16(v0[2], v0[3]); w.z = cvt_pk_bf16(v1[0], v1[1]); w.w = cvt_pk_bf16(v1[2], v1[3]);
                *(u32x4*)rowp = w; }
    }
};
struct EpiMoeDown {
    static constexpr bool PERM = false, AFTER_DRAIN = false;
    const int* row_tok; const float* row_w; float* h;
    __device__ __forceinline__ void operator()(const f32x4 (&acc)[2][2][4][2], const Unit& u, int wr, int wc, int fr, int fq) const {
        const int rloc = u.pm * BM + wr * 64 + fr, col0 = u.pn * BM + wc * 32 + 4 * fq;
#pragma unroll
        for (int ai = 0; ai < 2; ++ai)
#pragma unroll
            for (int m = 0; m < 4; ++m) { const int r = rloc + ai * HALF + m * 16; const int tok = row_tok[r]; const float w = row_w[r];
                if (tok >= 0) { float* p = h + (size_t)tok * 2048 + col0;
#pragma unroll
                    for (int bj = 0; bj < 2; ++bj)
#pragma unroll
                        for (int n = 0; n < 2; ++n) { const f32x4 bs = *(const f32x4*)(p + bj * HALF + n * 16); *(f32x4*)(p + bj * HALF + n * 16) = bs + w * acc[ai][bj][m][n]; } }
                asm volatile("" ::: "memory"); }
    }
};
struct MoeOrder : StaticOrder {
    const PG8_LAS int* tile_e; size_t estride;
    __device__ __forceinline__ const char* bbase(const Gemm& g, const Unit& u) const { return (const char*)g.Bt + (size_t)__builtin_amdgcn_readfirstlane(tile_e[u.pm]) * estride; }
};
template <class Epi, class Sched, bool ALIGN_EPI = false, bool SP2 = false>
__device__ __forceinline__ void gemm_phase(PG8_LAS unsigned char* lds, const Gemm g, const Sched& S, const Epi& E) {
    const int tid = opaque_tid(), wid = __builtin_amdgcn_readfirstlane(tid >> 6), lane = tid & 63, wr = wid >> 2, wc = wid & 3, fr = lane & 15, fq = lane >> 4;
    const int K = g.K, nt = K / BK;
    unsigned voffA[2], voffB[2];
#pragma unroll
    for (int i = 0; i < 2; ++i) { int R, C; stage_rc(tid * 16 + i * 8192, R, C); const int Rb = Epi::PERM ? ((R & ~31) + perm32(R & 31)) : R;
        voffA[i] = (unsigned)(R * K + C) * 2u; voffB[i] = (unsigned)(Rb * K + C) * 2u; }
    const size_t kstep = (size_t)(BK * 2);
    const size_t hstep = (size_t)HALF * K * 2;
    const size_t tstep = 2 * hstep;
    const unsigned ldsw = (unsigned)wid * 1024u;
    const int aoff = lds_byte(wr * 64 + fr, fq * 8), boff = lds_byte(wc * 32 + fr, fq * 8);
#define PG8_SA(b, h) (((b) * 2 + (h)) * HTB)
#define PG8_SB(b, h) ((4 + (b) * 2 + (h)) * HTB)
#define PG8_STAGE(bufoff, gbase, voff) do { _Pragma("unroll") for (int _i = 0; _i < 2; ++_i) \
        __builtin_amdgcn_global_load_lds((const unsigned*)((const char*)(gbase) + (voff)[_i]), (PG8_LAS unsigned*)(lds + (bufoff) + ldsw + _i * 8192), 16, 0, 0); } while (0)
#define PG8_LDA(dst, b, h) do { _Pragma("unroll") for (int m = 0; m < 4; ++m) _Pragma("unroll") for (int k = 0; k < 2; ++k) dst[m][k] = *(const PG8_LAS bf16x8*)(lds + PG8_SA(b, h) + aoff + m * 2048 + k * 1024); } while (0)
#define PG8_LDB(dst, b, h) do { _Pragma("unroll") for (int n = 0; n < 2; ++n) _Pragma("unroll") for (int k = 0; k < 2; ++k) dst[n][k] = *(const PG8_LAS bf16x8*)(lds + PG8_SB(b, h) + boff + n * 2048 + k * 1024); } while (0)
#define PG8_MMA(ai, bj, At, Bt) do { __builtin_amdgcn_s_setprio(1); _Pragma("unroll") for (int m = 0; m < 4; ++m) _Pragma("unroll") for (int n = 0; n < 2; ++n) _Pragma("unroll") for (int k = 0; k < 2; ++k) \
        acc[ai][bj][m][n] = __builtin_amdgcn_mfma_f32_16x16x32_bf16(Bt[n][k], At[m][k], acc[ai][bj][m][n], 0, 0, 0); __builtin_amdgcn_s_setprio(0); } while (0)
#define PG8_WAIT_V(n) asm volatile("s_waitcnt vmcnt(" #n ")" ::: "memory")
#define PG8_WAIT_L(n) asm volatile("s_waitcnt lgkmcnt(" #n ")" ::: "memory")
#define PG8_BAR __builtin_amdgcn_s_barrier()
#define PG8_SCHED __builtin_amdgcn_sched_barrier(0)
    Unit cur, nxt; int ui = 0;
    if (!S.next(0, cur)) return;
    f32x4 acc[2][2][4][2];
#pragma unroll
    for (int a = 0; a < 2; ++a)
#pragma unroll
        for (int b = 0; b < 2; ++b)
#pragma unroll
            for (int m = 0; m < 4; ++m)
#pragma unroll
                for (int n = 0; n < 2; ++n) acc[a][b][m][n] = (f32x4){0.f, 0.f, 0.f, 0.f};
    bf16x8 At[4][2], B0[2][2], B1[2][2];
    const char* cA = (const char*)g.A + (size_t)cur.pm * tstep; const char* cB = S.bbase(g, cur) + (size_t)cur.pn * tstep;
    S.a_ready(cur);
    if constexpr (SP2) {
        PG8_STAGE(PG8_SB(0, 0), cB, voffB); PG8_STAGE(PG8_SB(0, 1), cB + hstep, voffB); PG8_STAGE(PG8_SA(0, 0), cA, voffA); PG8_STAGE(PG8_SA(0, 1), cA + hstep, voffA);
        if (wr == 1) PG8_BAR;
        PG8_WAIT_V(2); PG8_BAR;
        PG8_STAGE(PG8_SB(1, 0), cB + kstep, voffB); PG8_STAGE(PG8_SA(1, 0), cA + kstep, voffA); PG8_STAGE(PG8_SB(1, 1), cB + hstep + kstep, voffB);
        PG8_WAIT_V(6); PG8_BAR;
    } else {
        PG8_STAGE(PG8_SB(0, 0), cB, voffB); PG8_STAGE(PG8_SA(0, 0), cA, voffA); PG8_STAGE(PG8_SB(0, 1), cB + hstep, voffB); PG8_STAGE(PG8_SA(0, 1), cA + hstep, voffA);
        if (wr == 1) PG8_BAR;
        PG8_WAIT_V(4); PG8_BAR;
        PG8_STAGE(PG8_SB(1, 0), cB + kstep, voffB); PG8_STAGE(PG8_SA(1, 0), cA + kstep, voffA); PG8_STAGE(PG8_SB(1, 1), cB + hstep + kstep, voffB);
        PG8_WAIT_V(6); PG8_BAR;
    }
    for (;;) {
        const bool has_next = S.next(ui + 1, nxt);
        const char* nA = has_next ? (const char*)g.A + (size_t)nxt.pm * tstep : cA; const char* nB = has_next ? S.bbase(g, nxt) + (size_t)nxt.pn * tstep : cB;
        for (int t = 0; t < nt; t += 2) {
            const bool last = (t == nt - 2);
            const char* a1 = cA + (size_t)(t + 1) * kstep;
            const char* a2 = last ? nA : cA + (size_t)(t + 2) * kstep; const char* b2 = last ? nB : cB + (size_t)(t + 2) * kstep;
            const char* a3 = a2 + kstep; const char* b3 = b2 + kstep;
            if (last && has_next) S.a_ready(nxt);
            if constexpr (SP2) {
            PG8_LDB(B0, 0, 0); PG8_LDB(B1, 0, 1); PG8_SCHED; PG8_LDA(At, 0, 0); PG8_STAGE(PG8_SA(1, 1), a1 + hstep, voffA);
            PG8_WAIT_V(8); PG8_WAIT_L(0); PG8_BAR; PG8_MMA(0, 0, At, B0); PG8_MMA(0, 1, At, B1); PG8_BAR; PG8_SCHED;
            PG8_LDA(At, 0, 1); PG8_STAGE(PG8_SB(0, 0), b2, voffB); PG8_STAGE(PG8_SB(0, 1), b2 + hstep, voffB); PG8_STAGE(PG8_SA(0, 0), a2, voffA);
            PG8_WAIT_V(8); PG8_WAIT_L(0); PG8_BAR; PG8_MMA(1, 0, At, B0); PG8_MMA(1, 1, At, B1); PG8_BAR; PG8_SCHED;
            PG8_LDB(B0, 1, 0); PG8_LDB(B1, 1, 1); PG8_SCHED; PG8_LDA(At, 1, 0); PG8_STAGE(PG8_SA(0, 1), a2 + hstep, voffA);
            PG8_WAIT_V(8); PG8_WAIT_L(0); PG8_BAR; PG8_MMA(0, 0, At, B0); PG8_MMA(0, 1, At, B1); PG8_BAR; PG8_SCHED;
            PG8_LDA(At, 1, 1); PG8_STAGE(PG8_SB(1, 0), b3, voffB); PG8_STAGE(PG8_SB(1, 1), b3 + hstep, voffB); PG8_STAGE(PG8_SA(1, 0), a3, voffA);
            PG8_WAIT_V(8); PG8_WAIT_L(0); PG8_BAR; PG8_MMA(1, 0, At, B0); PG8_MMA(1, 1, At, B1); PG8_BAR; PG8_SCHED;
            } else {
            PG8_LDB(B0, 0, 0); PG8_SCHED; PG8_LDA(At, 0, 0); PG8_STAGE(PG8_SA(1, 1), a1 + hstep, voffA);
            PG8_WAIT_L(8); PG8_BAR; PG8_WAIT_L(0); PG8_MMA(0, 0, At, B0); PG8_BAR; PG8_SCHED;
            PG8_LDB(B1, 0, 1); PG8_STAGE(PG8_SB(0, 0), b2, voffB);
            PG8_BAR; PG8_WAIT_L(0); PG8_MMA(0, 1, At, B1); PG8_BAR;
            PG8_LDA(At, 0, 1); PG8_STAGE(PG8_SA(0, 0), a2, voffA);
            PG8_BAR; PG8_WAIT_L(0); PG8_MMA(1, 0, At, B0); PG8_BAR; PG8_SCHED;
            PG8_STAGE(PG8_SB(0, 1), b2 + hstep, voffB);
            PG8_WAIT_V(6); PG8_BAR; PG8_MMA(1, 1, At, B1); PG8_BAR;
            PG8_LDB(B0, 1, 0); PG8_SCHED; PG8_LDA(At, 1, 0); PG8_STAGE(PG8_SA(0, 1), a2 + hstep, voffA);
            PG8_WAIT_L(8); PG8_BAR; PG8_WAIT_L(0); PG8_MMA(0, 0, At, B0); PG8_BAR; PG8_SCHED;
            PG8_LDB(B1, 1, 1); PG8_STAGE(PG8_SB(1, 0), b3, voffB);
            PG8_BAR; PG8_WAIT_L(0); PG8_MMA(0, 1, At, B1); PG8_BAR;
            PG8_LDA(At, 1, 1); PG8_STAGE(PG8_SA(1, 0), a3, voffA);
            PG8_BAR; PG8_WAIT_L(0); PG8_MMA(1, 0, At, B0); PG8_BAR; PG8_SCHED;
            PG8_STAGE(PG8_SB(1, 1), b3 + hstep, voffB);
            PG8_WAIT_V(6); PG8_BAR; PG8_MMA(1, 1, At, B1); PG8_BAR;
            }
        }
        if constexpr (ALIGN_EPI) { if (wr == 0) PG8_BAR; }
        if constexpr (!Epi::AFTER_DRAIN) { E(acc, cur, wr, wc, fr, fq); S.done(cur); }
        if (!has_next) break;
#pragma unroll
        for (int a = 0; a < 2; ++a)
#pragma unroll
            for (int b = 0; b < 2; ++b)
#pragma unroll
                for (int m = 0; m < 4; ++m)
#pragma unroll
                    for (int n = 0; n < 2; ++n) acc[a][b][m][n] = (f32x4){0.f, 0.f, 0.f, 0.f};
        cur = nxt; cA = nA; cB = nB; ++ui;
        if constexpr (ALIGN_EPI) { if (wr == 1) PG8_BAR; }
    }
    PG8_WAIT_V(0);
    if constexpr (!ALIGN_EPI) { if (wr == 0) PG8_BAR; }
    PG8_BAR;
    if constexpr (Epi::AFTER_DRAIN) { E.fused(acc, cur, wr, wc, fr, fq, lds, wid, lane); S.done(cur); }
#undef PG8_SA
#undef PG8_SB
#undef PG8_STAGE
#undef PG8_LDA
#undef PG8_LDB
#undef PG8_MMA
#undef PG8_WAIT_V
#undef PG8_WAIT_L
#undef PG8_BAR
#undef PG8_SCHED
}
}

namespace fox {
constexpr int D = 128, PITCH = 1024;
constexpr float THR = 8.f;
constexpr bool WSKIP = false;
constexpr float INV_SCALE = 11.313708498984761f;
constexpr float SCALE = 0.08838834764831845f;
constexpr int NW = 8, QBLK = 32, KVBLK = 64, QB = NW * QBLK;
constexpr int SHM_V = KVBLK * D * 2, SHM_K = KVBLK * D * 2;
constexpr int BIAS_OFF = 2 * SHM_V + 2 * SHM_K + NW * 64 * 4;
constexpr int LDS_BYTES = BIAS_OFF + 2 * 64 * 4;

typedef unsigned short bf16;
typedef short bf16x8 __attribute__((ext_vector_type(8)));
typedef short s16x4 __attribute__((ext_vector_type(4)));
typedef float f32x16 __attribute__((ext_vector_type(16)));
typedef float f32x4 __attribute__((ext_vector_type(4)));
typedef unsigned u32x4 __attribute__((ext_vector_type(4)));
template <class A, class Bt> struct same_t { static constexpr bool v = false; };
template <class A> struct same_t<A, A> { static constexpr bool v = true; };

#define KSWZ(row, colB) ((row) * 256 + ((colB) ^ (((row) & 7) << 4)))
#define SBAR() __builtin_amdgcn_sched_barrier(0)
__device__ __forceinline__ int v_st(int k, int c) { const int kk = (k & ~0xC) | ((k & 4) << 1) | ((k & 8) >> 1); return ((kk >> 3) * 4 + (c >> 5)) * 512 + ((kk & 7) * 32 + (c & 31)) * 2; }
__device__ __forceinline__ int v_rd_base(int lane) { return ((lane & 3) << 3) | (((lane >> 2) & 3) << 6) | (((lane >> 4) & 1) << 5) | (((lane >> 5) & 1) << 8); }
constexpr int v_rd_off(int d0, int ks, int half) { return d0 * 512 + ks * 4096 + half * 2048; }
__device__ __forceinline__ int crow(int r, int hi) { return (r & 3) + 8 * (r >> 2) + 4 * hi; }
__device__ __forceinline__ unsigned cvtpk(float lo, float hi) {
    unsigned r; asm volatile("v_cvt_pk_bf16_f32 %0, %1, %2" : "=v"(r) : "v"(lo), "v"(hi)); return r;
}
__device__ __forceinline__ bf16x8 pack8(f32x4 a, f32x4 b) {
    u32x4 w = {cvtpk(a[0], a[1]), cvtpk(a[2], a[3]), cvtpk(b[0], b[1]), cvtpk(b[2], b[3])};
    return *reinterpret_cast<bf16x8*>(&w);
}
template <class T> __device__ __forceinline__ bf16x8 load8(const T* p) {
    if constexpr (same_t<T, float>::v) { return pack8(*(const f32x4*)p, *(const f32x4*)(p + 4)); }
    else { return *reinterpret_cast<const bf16x8*>(p); }
}
__device__ __forceinline__ void mask_tile(f32x16& p0, f32x16& p1, int dq, unsigned W) {
    const float NEG = -__builtin_inff();
#pragma unroll
    for (int r = 0; r < 16; ++r) {
        const int c = (r & 3) + 8 * (r >> 2);
        if ((unsigned)(dq - c) >= W) p0[r] = NEG;
        if ((unsigned)(dq - c - 32) >= W) p1[r] = NEG;
    }
}
__device__ __forceinline__ void partialSM(f32x16& p0, f32x16& p1, float& m_reg, float& mn, float& alpha) {
    float pmax = p0[0]; for (int r = 1; r < 16; ++r) pmax = fmaxf(pmax, p0[r]); for (int r = 0; r < 16; ++r) pmax = fmaxf(pmax, p1[r]);
    { auto rr = __builtin_amdgcn_permlane32_swap(__float_as_uint(pmax), __float_as_uint(pmax), false, false);
      pmax = fmaxf(__uint_as_float(rr[0]), __uint_as_float(rr[1])); }
    constexpr float C2 = 1.4426950408889634f * SCALE;
    if (__builtin_expect(__all((pmax - m_reg) * SCALE <= THR), 1)) { mn = m_reg; alpha = 1.f; }
    else { mn = fmaxf(m_reg, pmax); alpha = __builtin_amdgcn_exp2f((m_reg - mn) * C2); m_reg = mn; }
    const float mnL = -mn * C2;
    for (int r = 0; r < 16; ++r) p0[r] = fmaf(p0[r], C2, mnL); for (int r = 0; r < 16; ++r) p1[r] = fmaf(p1[r], C2, mnL);
    for (int r = 0; r < 16; ++r) p0[r] = __builtin_amdgcn_exp2f(p0[r]);
}
__device__ __forceinline__ void finishSM(f32x16& p0, f32x16& p1, float alpha, float& l_reg, bf16x8& pa0, bf16x8& pa1, bf16x8& pa2, bf16x8& pa3) {
    for (int r = 0; r < 16; ++r) p1[r] = __builtin_amdgcn_exp2f(p1[r]);
    float ps = 0; for (int r = 0; r < 16; ++r) ps += p0[r]; for (int r = 0; r < 16; ++r) ps += p1[r];
    { auto rr = __builtin_amdgcn_permlane32_swap(__float_as_uint(ps), __float_as_uint(ps), false, false);
      ps = __uint_as_float(rr[0]) + __uint_as_float(rr[1]); }
    l_reg = l_reg * alpha + ps;
#define PK4(P, B_, OUT) do { unsigned a0 = cvtpk(P[B_+0], P[B_+1]), a1 = cvtpk(P[B_+2], P[B_+3]);                          \
        unsigned b0 = cvtpk(P[B_+4], P[B_+5]), b1 = cvtpk(P[B_+6], P[B_+7]);                                             \
        auto r0 = __builtin_amdgcn_permlane32_swap(a0, b0, false, false); auto r1 = __builtin_amdgcn_permlane32_swap(a1, b1, false, false); \
        u32x4 w = {r0[0], r1[0], r0[1], r1[1]}; OUT = *reinterpret_cast<bf16x8*>(&w); } while (0)
    PK4(p0, 0, pa0); PK4(p0, 8, pa1); PK4(p1, 0, pa2); PK4(p1, 8, pa3);
#undef PK4
}
template <int KB, bool SK>
__device__ __forceinline__ void qkt(f32x16& p0, f32x16& p1, const char* K_lds, int r32, int hi, const bf16x8* qr, bool act) {
    if (SK && !act) { const float NEG = -__builtin_inff();
#pragma unroll
        for (int r = 0; r < 16; ++r) { p0[r] = NEG; p1[r] = NEG; } return; }
    { const f32x4* bb = (const f32x4*)(K_lds + 2 * SHM_K + NW * 64 * 4 + KB * 256 + hi * 16);
#pragma unroll
      for (int g = 0; g < 4; ++g) { const f32x4 t0 = bb[2 * g], t1 = bb[8 + 2 * g];
#pragma unroll
          for (int i = 0; i < 4; ++i) { p0[4 * g + i] = t0[i]; p1[4 * g + i] = t1[i]; } } }
    const char* kb[4];
#pragma unroll
    for (int dd = 0; dd < 4; ++dd) kb[dd] = K_lds + KB * SHM_K + KSWZ(r32, (dd * 16 + hi * 8) * 2);
#pragma unroll
    for (int d0 = 0; d0 < 8; ++d0) { const char* a = kb[d0 & 3] + (d0 >> 2) * 128;
        bf16x8 b0 = *reinterpret_cast<const bf16x8*>(a);
        bf16x8 b1 = *reinterpret_cast<const bf16x8*>(a + 32 * 256);
        p0 = __builtin_amdgcn_mfma_f32_32x32x16_bf16(b0, qr[d0], p0, 0, 0, 0);
        p1 = __builtin_amdgcn_mfma_f32_32x32x16_bf16(b1, qr[d0], p1, 0, 0, 0); }
}
template <int VB, bool SK>
__device__ __forceinline__ void pv_tile(f32x16* o, int vb0, bf16x8 pa0, bf16x8 pa1, bf16x8 pa2, bf16x8 pa3, bool act) {
    if (SK && !act) return;
#define TRRD(dst, off) asm volatile("ds_read_b64_tr_b16 %0, %1 offset:%2" : "=&v"(dst) : "v"(vb0), "i"(off) : "memory")
#define PV_D0(d0) do { s16x4 l0, l1, l2, l3, h0, h1, h2, h3; constexpr int b_ = VB * SHM_V + v_rd_off(d0, 0, 0);     \
        TRRD(l0, b_); TRRD(h0, b_ + 2048); TRRD(l1, b_ + 4096); TRRD(h1, b_ + 6144); TRRD(l2, b_ + 8192); TRRD(h2, b_ + 10240); TRRD(l3, b_ + 12288); TRRD(h3, b_ + 14336); \
        asm volatile("s_waitcnt lgkmcnt(0)" ::: "memory"); SBAR();                 \
        o[d0] = __builtin_amdgcn_mfma_f32_32x32x16_bf16(pa0, (bf16x8){l0[0], l0[1], l0[2], l0[3], h0[0], h0[1], h0[2], h0[3]}, o[d0], 0, 0, 0);   \
        o[d0] = __builtin_amdgcn_mfma_f32_32x32x16_bf16(pa1, (bf16x8){l1[0], l1[1], l1[2], l1[3], h1[0], h1[1], h1[2], h1[3]}, o[d0], 0, 0, 0);   \
        o[d0] = __builtin_amdgcn_mfma_f32_32x32x16_bf16(pa2, (bf16x8){l2[0], l2[1], l2[2], l2[3], h2[0], h2[1], h2[2], h2[3]}, o[d0], 0, 0, 0);   \
        o[d0] = __builtin_amdgcn_mfma_f32_32x32x16_bf16(pa3, (bf16x8){l3[0], l3[1], l3[2], l3[3], h3[0], h3[1], h3[2], h3[3]}, o[d0], 0, 0, 0); } while (0)
    PV_D0(0); PV_D0(1); PV_D0(2); PV_D0(3);
#undef PV_D0
#undef TRRD
}

template <class TIn, class TOut> struct BlockRef { const TIn* Q; const TIn* K; const TIn* V; TOut* O; const float* cb; float cref; int P0; int jlo; };
template <class TIn> struct Seam {
    bf16x8 qr[8];
    bf16x8 st_v0, st_v1, st_k0, st_k1; float st_c; f32x4 sf0, sf1, sf2, sf3;
    f32x4 tq[16];
};
__device__ __forceinline__ int swa_jlo(int P0, int W) { const int lowk = P0 - W + 1; return lowk > 0 ? lowk / KVBLK : 0; }
#define ROW(p, k0, rr) ((p) + (size_t)((k0) + (rr)) * PITCH + sc)
#define VMW() asm volatile("s_waitcnt vmcnt(0)" ::: "memory")
#define VMWN(n) asm volatile("s_waitcnt vmcnt(%0)" :: "i"(n) : "memory")
#define SLOAD_H(Kp, Vp, Cp, k0) do { S.st_v0 = load8<TIn>(ROW(Vp, k0, sr)); S.st_v1 = load8<TIn>(ROW(Vp, k0, 32 + sr));              \
                         S.st_k0 = load8<TIn>(ROW(Kp, k0, sr)); S.st_k1 = load8<TIn>(ROW(Kp, k0, 32 + sr)); S.st_c = (Cp)[(k0) + lane]; } while (0)
#define SWRITE_HK(bf, cr) do { *(bf16x8*)(K_lds + (bf) * SHM_K + kws) = S.st_k0; *(bf16x8*)(K_lds + (bf) * SHM_K + kws + 32 * 256) = S.st_k1; \
                            if (wid == 0) ((float*)(K_lds + 2 * SHM_K + NW * 64 * 4))[(bf) * 64 + lane] = ((cr) - S.st_c) * INV_SCALE; } while (0)
#define SWRITE_HV(bf) do { *(bf16x8*)(V_lds + (bf) * SHM_V + vst0) = S.st_v0; *(bf16x8*)(V_lds + (bf) * SHM_V + vst1) = S.st_v1; } while (0)
#define SWRITE_H(bf, cr) do { SWRITE_HV(bf); SWRITE_HK(bf, cr); } while (0)
#define SLOAD_F(p, k0) do { S.sf0 = *(const f32x4*)ROW(p, k0, sr); S.sf1 = *(const f32x4*)(ROW(p, k0, sr) + 4);                \
                            S.sf2 = *(const f32x4*)ROW(p, k0, 32 + sr); S.sf3 = *(const f32x4*)(ROW(p, k0, 32 + sr) + 4); } while (0)
#define SWRITE_KF(bf) do { *(bf16x8*)(K_lds + (bf) * SHM_K + kws) = pack8(S.sf0, S.sf1); *(bf16x8*)(K_lds + (bf) * SHM_K + kws + 32 * 256) = pack8(S.sf2, S.sf3); } while (0)
#define SWRITE_VF(bf) do { *(bf16x8*)(V_lds + (bf) * SHM_V + vst0) = pack8(S.sf0, S.sf1); *(bf16x8*)(V_lds + (bf) * SHM_V + vst1) = pack8(S.sf2, S.sf3); } while (0)
template <class TIn, class TOut>
__device__ __forceinline__ void causal_swa_prime(const BlockRef<TIn, TOut>& cur, int W, char* lds, Seam<TIn>& S) {
    constexpr bool F32 = same_t<TIn, float>::v;
    const int tid = pg8::opaque_tid(), wid = __builtin_amdgcn_readfirstlane(tid >> 6), lane = tid & 63, r32 = lane & 31, hi = lane >> 5;
    const int sr = tid >> 4, sc = (tid & 15) * 8, kws = KSWZ(sr, sc * 2); char* K_lds = lds + 2 * SHM_V;
    const int kb0 = cur.jlo * KVBLK;
    for (int d0 = 0; d0 < 8; ++d0) S.qr[d0] = load8<TIn>(cur.Q + (size_t)(wid * QBLK + r32) * PITCH + d0 * 16 + hi * 8);
    if constexpr (F32) { SLOAD_F((const float*)cur.K, kb0); VMW(); SWRITE_KF(0); SBAR(); SLOAD_F((const float*)cur.V, kb0); }
    else { SLOAD_H(cur.K, cur.V, cur.cb, kb0); VMW(); SWRITE_HK(0, cur.cref); }
    __syncthreads();
}
template <class TIn, class TOut>
__device__ __forceinline__ void causal_swa_block(const BlockRef<TIn, TOut>& cur, const BlockRef<TIn, TOut>& nxt, int skv, int W, char* lds, Seam<TIn>& S) {
    constexpr bool F32 = same_t<TIn, float>::v;
    const int tid = pg8::opaque_tid(), wid = __builtin_amdgcn_readfirstlane(tid >> 6), lane = tid & 63, r32 = lane & 31, hi = lane >> 5;
    const int j_lo = cur.jlo;
    int j_hi = (cur.P0 + QB - 1) / KVBLK + 1; if (j_hi > skv / KVBLK) j_hi = skv / KVBLK;
    const int NT = j_hi - j_lo;
    const int kbn = nxt.jlo * KVBLK;
    const int qlo = cur.P0 + wid * QBLK, qm = qlo + r32 - 4 * hi;
    char* V_lds = lds; char* K_lds = lds + 2 * SHM_V;
    float* ws = (float*)(lds + 2 * SHM_V + 2 * SHM_K) + wid * 64; float* li_l = ws, * al_l = ws + 32;
    float m_reg = -1e30f, l_reg = 0; f32x16 o[4] = {};
    const int sr = tid >> 4, sc = (tid & 15) * 8, vst0 = v_st(sr, sc), vst1 = v_st(32 + sr, sc), kws = KSWZ(sr, sc * 2);
    const int vb0 = (int)(uintptr_t)V_lds + v_rd_base(lane);
    const TIn* Kh = cur.K; const TIn* Vh = cur.V;
#define RESC(a) do { if (__any((a) < 1.f)) { if (hi == 0) al_l[r32] = (a); asm volatile("s_waitcnt lgkmcnt(0)" ::: "memory");              \
                     for (int d_ = 0; d_ < 4; ++d_) for (int r = 0; r < 16; ++r) o[d_][r] *= al_l[crow(r, hi)]; } } while (0)
#define KBASE(t) ((j_lo + (t)) * KVBLK)
#define ACT(t) (KBASE(t) <= qlo + QBLK - 1 && KBASE(t) + KVBLK - 1 >= qlo - W + 1)
#define MASKT(P0_, P1_, t) do { const int kb_ = KBASE(t); if ((!SK || ACT(t)) && (kb_ + KVBLK - 1 > qlo || kb_ <= qlo + QBLK - 1 - W)) mask_tile(P0_, P1_, qm - kb_, (unsigned)W); } while (0)
    constexpr int NQL = F32 ? 16 : 8;
    constexpr bool SK = WSKIP && !F32;
#define SEAM_K0() do { VMWN(NQL); if constexpr (F32) { SWRITE_KF(0); SBAR(); SLOAD_F((const float*)nxt.V, kbn); } else { SWRITE_HK(0, nxt.cref); } SBAR(); } while (0)
    f32x16 pA0, pA1, pB0, pB1; float mnA, mnB, alA, alB; bf16x8 pa0, pa1, pa2, pa3;
    if constexpr (F32) { VMW(); SWRITE_VF(0); SBAR(); } else { SWRITE_HV(0); SBAR(); }
    if (NT > 1) { if constexpr (F32) SLOAD_F((const float*)Kh, KBASE(1)); else SLOAD_H(Kh, Vh, cur.cb, KBASE(1)); }
    SBAR(); qkt<0, SK>(pA0, pA1, K_lds, r32, hi, S.qr, ACT(0));
    if constexpr (F32) { if (NT > 1) { VMW(); SWRITE_KF(1); SBAR(); SLOAD_F((const float*)Vh, KBASE(1)); } }
    MASKT(pA0, pA1, 0); partialSM(pA0, pA1, m_reg, mnA, alA);
    if (NT > 1) { VMW(); if constexpr (F32) { SWRITE_VF(1); SBAR(); if (NT > 2) SLOAD_F((const float*)Kh, KBASE(2)); } else SWRITE_H(1, cur.cref); }
    __syncthreads();
#define HALF_STEP(PX0, PX1, mnX, alX, PY0, PY1, alY, t, KB, VB, SB) do {                                                      \
        SBAR(); qkt<KB, SK>(PX0, PX1, K_lds, r32, hi, S.qr, ACT(t));                                             \
        finishSM(PY0, PY1, alY, l_reg, pa0, pa1, pa2, pa3); SBAR();                                                           \
        if ((t) + 1 < NT) { if constexpr (F32) { VMW(); SWRITE_KF(SB); SBAR(); SLOAD_F((const float*)Vh, KBASE((t) + 1)); }  \
                            else { SLOAD_H(Kh, Vh, cur.cb, KBASE((t) + 1)); } SBAR(); }                                               \
        pv_tile<VB, SK>(o, vb0, pa0, pa1, pa2, pa3, ACT((t) - 1)); MASKT(PX0, PX1, (t)); partialSM(PX0, PX1, m_reg, mnX, alX);                                        \
        __syncthreads();                                                                                                      \
        if ((t) + 1 < NT) { VMW(); if constexpr (F32) { SWRITE_VF(SB); SBAR(); if ((t) + 2 < NT) SLOAD_F((const float*)Kh, KBASE((t) + 2)); } \
                            else { SWRITE_H(SB, cur.cref); } }                                                                          \
        RESC(alX); __syncthreads(); } while (0)
    for (int t = 1; t + 1 < NT; t += 2) {
        HALF_STEP(pB0, pB1, mnB, alB, pA0, pA1, alA, t, 1, 0, 0);
        HALF_STEP(pA0, pA1, mnA, alA, pB0, pB1, alB, t + 1, 0, 1, 1);
    }
    const bool even = (NT & 1) == 0;
    if (even) { SBAR(); qkt<1, SK>(pB0, pB1, K_lds, r32, hi, S.qr, ACT(NT - 1)); SBAR(); }
#define QROW(e) (nxt.Q + (size_t)(wid * QBLK + r32) * PITCH + ((e) >> 1) * 16 + hi * 8 + ((e) & 1) * 4)
    if constexpr (F32) { SLOAD_F((const float*)nxt.K, kbn); SBAR();
#pragma unroll
        for (int e = 0; e < 8; ++e) S.tq[e] = *(const f32x4*)QROW(e); }
    else { SLOAD_H(nxt.K, nxt.V, nxt.cb, kbn); SBAR();
#pragma unroll
        for (int d0 = 0; d0 < 8; ++d0) S.qr[d0] = load8<TIn>(nxt.Q + (size_t)(wid * QBLK + r32) * PITCH + d0 * 16 + hi * 8); }
    SBAR();
    finishSM(pA0, pA1, alA, l_reg, pa0, pa1, pa2, pa3); SBAR();
    if constexpr (F32) {
#pragma unroll
        for (int e = 8; e < 16; ++e) S.tq[e] = *(const f32x4*)QROW(e); SBAR(); }
#undef QROW
    pv_tile<0, SK>(o, vb0, pa0, pa1, pa2, pa3, ACT(even ? NT - 2 : NT - 1));
    if (even) { MASKT(pB0, pB1, NT - 1); partialSM(pB0, pB1, m_reg, mnB, alB); __syncthreads(); RESC(alB);
        finishSM(pB0, pB1, alB, l_reg, pa0, pa1, pa2, pa3); SBAR(); pv_tile<1, SK>(o, vb0, pa0, pa1, pa2, pa3, ACT(NT - 1)); }
    SBAR(); SEAM_K0();
    if (hi == 0) li_l[r32] = l_reg; asm volatile("s_waitcnt lgkmcnt(0)" ::: "memory");
    float rli[16];
#pragma unroll
    for (int r = 0; r < 16; ++r) rli[r] = __builtin_amdgcn_rcpf(li_l[crow(r, hi)]);
    TOut* Ow = cur.O + (size_t)(wid * QBLK) * PITCH;
#pragma unroll
    for (int r = 0; r < 16; ++r) { const int orow = crow(r, hi);
#pragma unroll
        for (int d0 = 0; d0 < 4; ++d0) { const float v = o[d0][r] * rli[r];
            if constexpr (same_t<TOut, float>::v) { Ow[(size_t)orow * PITCH + d0 * 32 + r32] = v; }
            else { const float vn = __shfl_xor(v, 1);
                   if ((r32 & 1) == 0) *(unsigned*)(Ow + (size_t)orow * PITCH + d0 * 32 + r32) = cvtpk(v, vn); } } }
    if constexpr (F32) {
#pragma unroll
        for (int d0 = 0; d0 < 8; ++d0) S.qr[d0] = pack8(S.tq[2 * d0], S.tq[2 * d0 + 1]); }
    __syncthreads();
#undef RESC
#undef KBASE
#undef ACT
#undef MASKT
#undef SEAM_K0
#undef HALF_STEP
}
#undef ROW
#undef VMW
#undef VMWN
#undef SLOAD_H
#undef SWRITE_HK
#undef SWRITE_HV
#undef SWRITE_H
#undef SLOAD_F
#undef SWRITE_KF
#undef SWRITE_VF

}

#define GAS __attribute__((address_space(1)))
#define LAS __attribute__((address_space(3)))
typedef unsigned short bf16;
typedef unsigned v4u __attribute__((ext_vector_type(4)));
typedef float f32x4 __attribute__((ext_vector_type(4)));
typedef short bf16x8 __attribute__((ext_vector_type(8)));
typedef GAS unsigned gu32;
typedef GAS unsigned long long gu64;
#define RLX_AGENT __ATOMIC_RELAXED, __HIP_MEMORY_SCOPE_AGENT
#define LDS_WAIT() asm volatile("s_waitcnt lgkmcnt(0)" ::: "memory")
#define VM_WAIT() asm volatile("s_waitcnt vmcnt(0)" ::: "memory")
__device__ __forceinline__ unsigned long long rt() { return __builtin_amdgcn_s_memrealtime(); }
__device__ __forceinline__ unsigned f2bf(float f) { unsigned u = __builtin_bit_cast(unsigned, f); return (u + 0x7fffu + ((u >> 16) & 1u)) >> 16; }
__device__ __forceinline__ unsigned pk2(float lo, float hi) { return f2bf(lo) | (f2bf(hi) << 16); }

#define XB_TMO      128
#define XB_XCNT(j)  (256  + 64 * (j))
#define XB_XSUB(j)  (1280 + 64 * (j))
#define XB_XGEN(j)  (2304 + 64 * (j))
#define XB_TOP      3328
#define XB_TOPGEN   3392
#define XCD_BAR_WORDS 3456
#define XB_SPIN_CAP (1u << 21)

__device__ __forceinline__ unsigned xb_ld(unsigned* p)              { return __hip_atomic_load(p, __ATOMIC_RELAXED, __HIP_MEMORY_SCOPE_AGENT); }
__device__ __forceinline__ unsigned xb_add(unsigned* p, unsigned v) { return __hip_atomic_fetch_add(p, v, __ATOMIC_RELAXED, __HIP_MEMORY_SCOPE_AGENT); }
__device__ __forceinline__ unsigned xb_xcc_id() { return (unsigned)__builtin_amdgcn_s_getreg((3 << 11) | 20) & 0xFu; }
#define XB_SPIN(cond, bar) do { unsigned _sp = 0; while (cond) { __builtin_amdgcn_s_sleep(1); \
    if ((++_sp & 255u) == 0u) { if (xb_ld(&(bar)[XB_TMO])) break; if (_sp > XB_SPIN_CAP) { atomicAdd(&(bar)[XB_TMO], 1u); break; } } } } while (0)

struct XcdBarrier {
    unsigned* bar; unsigned x;
    volatile LAS unsigned* st;
};

__device__ __forceinline__ XcdBarrier xcd_barrier_post(unsigned* bar, volatile LAS unsigned* st) {
    XcdBarrier b; b.bar = bar; b.x = xb_xcc_id(); b.st = st;
    if (threadIdx.x == 0) (void)xb_add(&bar[XB_XCNT(b.x)], 1u);
    return b;
}
__device__ __forceinline__ void xcd_barrier_complete(unsigned* bar, unsigned x, unsigned& nloc, unsigned& nx) {
    const unsigned G = gridDim.x * gridDim.y * gridDim.z;
    unsigned sum, cnt, mine, sp = 0u;
    for (;;) {
        sum = 0u; cnt = 0u; mine = 0u;
#pragma unroll
        for (unsigned j = 0; j < 16; ++j) { const unsigned c = xb_ld(&bar[XB_XCNT(j)]); sum += c; cnt += (c > 0u) ? 1u : 0u; mine = (j == x) ? c : mine; }
        if (sum == G) break;
        __builtin_amdgcn_s_sleep(1);
        if ((++sp & 255u) == 0u) { if (xb_ld(&bar[XB_TMO])) break; if (sp > XB_SPIN_CAP) { atomicAdd(&bar[XB_TMO], 1u); break; } }
    }
    nloc = mine > 0u ? mine : 1u; nx = cnt > 0u ? cnt : 1u;
}

__device__ __forceinline__ void xcd_barrier(const XcdBarrier& b) {
    asm volatile("s_waitcnt vmcnt(0)" ::: "memory");
    __syncthreads();
    if (threadIdx.x == 0) {
        unsigned* bar = b.bar;
        __builtin_amdgcn_s_waitcnt(0);
        unsigned nloc = b.st[0], nx = b.st[1];
        if (nloc == 0u) { xcd_barrier_complete(bar, b.x, nloc, nx); b.st[0] = nloc; b.st[1] = nx; }
        const unsigned old = xb_add(&bar[XB_XSUB(b.x)], 1u);
        const unsigned gen = old / nloc;
        if (old + 1u == (gen + 1u) * nloc) {
            __builtin_amdgcn_fence(__ATOMIC_RELEASE, "agent");
            asm volatile("s_waitcnt vmcnt(0)" ::: "memory");
            const unsigned og = xb_add(&bar[XB_TOP], 1u);
            const unsigned tg = og / nx;
            if (og + 1u == (tg + 1u) * nx) xb_add(&bar[XB_TOPGEN], 1u);
            else XB_SPIN(xb_ld(&bar[XB_TOPGEN]) == tg, bar);
            __builtin_amdgcn_fence(__ATOMIC_ACQUIRE, "agent");
            xb_add(&bar[XB_XGEN(b.x)], 1u);
            asm volatile("s_waitcnt vmcnt(0)" ::: "memory");
        } else {
            XB_SPIN(xb_ld(&bar[XB_XGEN(b.x)]) == gen, bar);
            __builtin_amdgcn_fence(__ATOMIC_ACQUIRE, "agent");
            asm volatile("s_waitcnt vmcnt(0)" ::: "memory");
        }
    }
    __syncthreads();
}

constexpr int NWAVES = 8;
#ifndef MK_PER_PHASE
#define MK_PER_PHASE 0
#endif
constexpr int BATCH = 2, SEQ = 16384, DM = 2048, MTOK = BATCH * SEQ;
constexpr int DCONV = 1024, NH = 8, DATT = 1024, PTOT = 10248, NPROJ = 10240;
constexpr int DFF = 5632, NE = 8, DFFE = 7168;
constexpr int RMAX = MTOK + NE * 256;
constexpr float RMS_EPS = 1e-6f;
constexpr size_t MiB = 1u << 20;
constexpr size_t WS_CTL = 0, CTL_ZERO_BYTES = 1 * MiB;
constexpr size_t WS_LOGF = 1 * MiB;
constexpr size_t WS_CB = 2 * MiB;
constexpr size_t WS_TOKE = 3 * MiB;
constexpr size_t WS_TOKW = 3 * MiB + 512 * 1024;
constexpr size_t WS_ROWTOK = 4 * MiB;
constexpr size_t WS_ROWW = 5 * MiB;
constexpr size_t WS_WIN = 8 * MiB;
constexpr size_t WS_WCO = WS_WIN + 80 * MiB;
constexpr size_t WS_WAO = WS_WCO + 8 * MiB;
constexpr size_t WS_WO = WS_WAO + 8 * MiB;
constexpr size_t WS_WGU = WS_WO + 16 * MiB;
constexpr size_t WS_WDD = WS_WGU + 44 * MiB;
constexpr size_t WS_MWGU = WS_WDD + 22 * MiB;
constexpr size_t WS_MWD = WS_MWGU + 448 * MiB;
constexpr size_t WS_A = WS_MWD + 224 * MiB;
constexpr size_t WS_P6 = WS_A + 128 * MiB;
constexpr size_t WS_G = WS_P6 + 384 * MiB;
constexpr size_t WS_END = WS_G + 256 * MiB;
constexpr size_t WS_HID = WS_P6;
constexpr size_t WS_XG = WS_P6 + 476 * MiB;
static_assert((size_t)RMAX * DFFE * 2 <= 476 * MiB && WS_XG + (size_t)RMAX * DM * 2 <= WS_END && (size_t)MTOK * DFF * 2 <= 476 * MiB, "overlay");
static_assert((size_t)2 * NPROJ * DM * 2 == 80 * MiB && (size_t)2 * DFF * DM * 2 == 44 * MiB && (size_t)NE * 2 * DFFE * DM * 2 == 448 * MiB, "weights");
constexpr int CW_CNT = 64;
constexpr int CW_CUR = 128;
constexpr int CW_BAR = 4096;
constexpr int RING_BYTES = 131072;
constexpr int LDSCTL_OFF = RING_BYTES, MISC_OFF = LDSCTL_OFF + 320, TILE_E_OFF = LDSCTL_OFF + 1024;
constexpr int LDS_BYTES = 147456;
enum { I_X = 0, I_MIXN, I_WIN, I_BF, I_CONVW, I_WCO, I_WAO, I_WO, I_FFNN, I_DWG, I_DWU, I_DWD, I_RW, I_RB, I_MWG, I_MWU, I_MWD, I_FN, N_IN };

struct Args { const float* in[N_IN]; float* out; unsigned char* ws; int ph_lo, ph_hi; };
struct Frame { LAS unsigned char* lds; int tid, lane, wave, vcu, G; };
#define KAS __attribute__((address_space(4)))
typedef const KAS Args* ArgsP;

__device__ __forceinline__ float wave_sum(float v, int lane) {
#pragma unroll
    for (int o = 1; o < 64; o <<= 1) v += __int_as_float(__builtin_amdgcn_ds_bpermute((lane ^ o) << 2, __float_as_int(v)));
    return v;
}
struct CvtJob { const float* src; bf16* dst; int ldw, col_off, ncols, K, kind, row_off; };
__device__ __forceinline__ void get_job(ArgsP a, int j, CvtJob& J) {
    if (j < 4) { const int l = j >> 1, p = j & 1; J.src = a->in[I_WIN] + (size_t)l * DM * PTOT; J.ldw = PTOT; J.col_off = p ? 6152 : 0; J.ncols = p ? 4096 : 6144; J.K = DM;
        J.dst = (bf16*)(a->ws + WS_WIN) + (size_t)l * NPROJ * DM; J.kind = 0; J.row_off = p ? 6144 : 0; }
    else if (j < 8) { const int l = j & 1, w = (j - 4) >> 1; J.src = a->in[w ? I_WAO : I_WCO] + (size_t)l * 1024 * DM; J.ldw = DM; J.col_off = 0; J.ncols = DM; J.K = 1024;
        J.dst = (bf16*)(a->ws + (w ? WS_WAO : WS_WCO)) + (size_t)l * DM * 1024; J.kind = 0; J.row_off = 0; }
    else if (j < 10) { const int l = j & 1; J.src = a->in[I_WO] + (size_t)l * DM * DM; J.ldw = DM; J.col_off = 0; J.ncols = DM; J.K = DM; J.dst = (bf16*)(a->ws + WS_WO) + (size_t)l * DM * DM; J.kind = 0; J.row_off = 0; }
    else if (j < 12) { const int u = j - 10; J.src = a->in[u ? I_DWU : I_DWG]; J.ldw = DFF; J.col_off = 0; J.ncols = DFF; J.K = DM; J.dst = (bf16*)(a->ws + WS_WGU); J.kind = 1; J.row_off = u ? 128 : 0; }
    else if (j < 13) { J.src = a->in[I_DWD]; J.ldw = DM; J.col_off = 0; J.ncols = DM; J.K = DFF; J.dst = (bf16*)(a->ws + WS_WDD); J.kind = 0; J.row_off = 0; }
    else if (j < 29) { const int e = (j - 13) & 7, u = (j - 13) >> 3; J.src = a->in[u ? I_MWU : I_MWG] + (size_t)e * DM * DFFE; J.ldw = DFFE; J.col_off = 0; J.ncols = DFFE; J.K = DM;
        J.dst = (bf16*)(a->ws + WS_MWGU) + (size_t)e * 2 * DFFE * DM; J.kind = 1; J.row_off = u ? 128 : 0; }
    else { const int e = j - 29; J.src = a->in[I_MWD] + (size_t)e * DFFE * DM; J.ldw = DM; J.col_off = 0; J.ncols = DM; J.K = DFFE; J.dst = (bf16*)(a->ws + WS_MWD) + (size_t)e * DM * DFFE; J.kind = 0; J.row_off = 0; }
}
constexpr int N_CVT_JOBS = 37;
__device__ __forceinline__ void cvt_item(const CvtJob& J, int item, int lane) {
    const int nblk = J.ncols >> 5, kb = item / nblk, nb = item - kb * nblk;
    const int kq = lane >> 3, n4 = lane & 7;
    const float* s = J.src + (size_t)(kb * 64 + kq * 8) * J.ldw + J.col_off + nb * 32 + n4 * 4;
    f32x4 v[8];
#pragma unroll
    for (int e = 0; e < 8; ++e) v[e] = *(const GAS f32x4*)(s + (size_t)e * J.ldw);
    const int src_lane = ((lane & 7) << 3) | (lane >> 3);
    unsigned w[4][4];
#pragma unroll
    for (int j = 0; j < 4; ++j)
#pragma unroll
        for (int q = 0; q < 4; ++q) w[j][q] = (unsigned)__builtin_amdgcn_ds_bpermute(src_lane << 2, (int)pk2(v[2 * q][j], v[2 * q + 1][j]));
    const int n0 = nb * 32 + (lane >> 3) * 4, k0 = kb * 64 + (lane & 7) * 8;
    const int drow = (J.kind == 1 ? 256 * (n0 >> 7) + (n0 & 127) : n0) + J.row_off;
#pragma unroll
    for (int j = 0; j < 4; ++j) { v4u o; o.x = w[j][0]; o.y = w[j][1]; o.z = w[j][2]; o.w = w[j][3]; *(GAS v4u*)(J.dst + (size_t)(drow + j) * J.K + k0) = o; }
}
__device__ __forceinline__ void phase_convert(const Frame& F, ArgsP a) {
    const int gw = F.vcu * NWAVES + F.wave, NGW = F.G * NWAVES; int off = 0;
    for (int j = 0; j < N_CVT_JOBS; ++j) { CvtJob J; get_job(a, j, J); const int nit = (J.K >> 6) * (J.ncols >> 5);
        int i0 = (gw - off) % NGW; if (i0 < 0) i0 += NGW;
        for (int it = i0; it < nit; it += NGW) cvt_item(J, it, F.lane);
        off = (off + nit) % NGW; }
}
__device__ __forceinline__ float log_sigmoid(float x) {
    const float y = __builtin_amdgcn_exp2f(-1.4426950408889634f * __builtin_fabsf(x));
    const float l1p = y < 1e-3f ? y * (1.0f - 0.5f * y) : 0.6931471805599453f * __builtin_amdgcn_logf(1.0f + y);
    return fminf(x, 0.f) - l1p;
}
__device__ __forceinline__ void stage_w8(const Frame& F, const float* w8, int ldw) {
    LAS float* wl = (LAS float*)F.lds;
    for (int col = F.tid; col < DM; col += NWAVES * 64) { const int j = col >> 8, ln = (col & 255) >> 2, e = col & 3;
        const f32x4 a = *(const GAS f32x4*)(w8 + (size_t)col * ldw), b = *(const GAS f32x4*)(w8 + (size_t)col * ldw + 4);
        LAS f32x4* d = (LAS f32x4*)(wl + ((j * 4 + e) * 64 + ln) * 8); d[0] = a; d[1] = b; }
    __syncthreads();
}
template <int MODE>
__device__ __forceinline__ void phase_norm(const Frame& F, ArgsP a, const float* hin, const float* gain, bf16* aout, float* fout, const float* w8, int ldw8, const float* b8) {
    if (MODE == 0 || MODE == 2) stage_w8(F, w8, ldw8);
    const LAS float* wl = (const LAS float*)F.lds;
    f32x4 g[8];
#pragma unroll
    for (int j = 0; j < 8; ++j) g[j] = *(const GAS f32x4*)(gain + 256 * j + 4 * F.lane);
    float bb[8];
#pragma unroll
    for (int h = 0; h < 8; ++h) bb[h] = (MODE == 0 || MODE == 2) ? b8[h] : 0.f;
    const int RPW = MTOK / (F.G * NWAVES);
    const int gw = F.vcu * NWAVES + F.wave; const int r0 = gw * RPW;
    float* logf = (float*)(a->ws + WS_LOGF); int* tokE = (int*)(a->ws + WS_TOKE); float* tokW = (float*)(a->ws + WS_TOKW);
    int mycnt = 0;
    for (int r = r0; r < r0 + RPW; ++r) {
        const GAS f32x4* xr = (const GAS f32x4*)(hin + (size_t)r * DM) + F.lane;
        f32x4 v[8]; float ss = 0.f;
#pragma unroll
        for (int j = 0; j < 8; ++j) { v[j] = xr[64 * j]; ss += (v[j].x * v[j].x + v[j].y * v[j].y) + (v[j].z * v[j].z + v[j].w * v[j].w); }
        const float rstd = 1.0f / sqrtf(wave_sum(ss, F.lane) * (1.0f / DM) + RMS_EPS);
#pragma unroll
        for (int j = 0; j < 8; ++j) v[j] = v[j] * rstd * g[j];
        if (MODE == 3) { GAS f32x4* o = (GAS f32x4*)(fout + (size_t)r * DM) + F.lane;
#pragma unroll
            for (int j = 0; j < 8; ++j) o[64 * j] = v[j]; }
        else { GAS unsigned long long* o8 = (GAS unsigned long long*)(aout + (size_t)r * DM) + F.lane;
#pragma unroll
            for (int j = 0; j < 8; ++j) o8[64 * j] = (unsigned long long)pk2(v[j].x, v[j].y) | ((unsigned long long)pk2(v[j].z, v[j].w) << 32); }
        if (MODE == 0 || MODE == 2) {
            float acc[8];
#pragma unroll
            for (int h = 0; h < 8; ++h) acc[h] = 0.f;
#pragma unroll
            for (int j = 0; j < 8; ++j) { asm volatile("" ::: "memory");
#pragma unroll
                for (int e = 0; e < 4; ++e) { const LAS f32x4* wp = (const LAS f32x4*)(wl + ((j * 4 + e) * 64 + F.lane) * 8); const f32x4 w0 = wp[0], w1 = wp[1]; const float x = v[j][e];
                    acc[0] += x * w0.x; acc[1] += x * w0.y; acc[2] += x * w0.z; acc[3] += x * w0.w; acc[4] += x * w1.x; acc[5] += x * w1.y; acc[6] += x * w1.z; acc[7] += x * w1.w; } }
#pragma unroll
            for (int h = 0; h < 8; ++h) acc[h] = wave_sum(acc[h], F.lane) + bb[h];
            if (MODE == 0) {
                float mine = acc[0];
#pragma unroll
                for (int h = 1; h < 8; ++h) mine = (F.lane == h) ? acc[h] : mine;
                if (F.lane < 8) logf[(size_t)r * 8 + F.lane] = log_sigmoid(mine);
            } else {
                int i1 = 0; float l1 = acc[0];
#pragma unroll
                for (int h = 1; h < 8; ++h) if (acc[h] > l1) { l1 = acc[h]; i1 = h; }
                int i2 = -1; float l2 = -3.0e38f;
#pragma unroll
                for (int h = 0; h < 8; ++h) if (h != i1 && acc[h] > l2) { l2 = acc[h]; i2 = h; }
                const float w1 = 1.0f / (1.0f + __builtin_amdgcn_exp2f(1.4426950408889634f * (l2 - l1))), w2 = 1.0f - w1;
                if (F.lane == 0) { tokE[2 * r] = i1; tokE[2 * r + 1] = i2; tokW[2 * r] = w1; tokW[2 * r + 1] = w2; }
                if (F.lane < 16) mycnt += ((F.lane < 8 ? i1 : i2) == (F.lane & 7)) ? 1 : 0;
            }
        }
    }
    if (MODE == 2) {
        if (F.lane < 16 && mycnt) __hip_atomic_fetch_add((unsigned*)a->ws + CW_CNT + F.lane, (unsigned)mycnt, __ATOMIC_RELAXED, __HIP_MEMORY_SCOPE_AGENT);
        int* rt = (int*)(a->ws + WS_ROWTOK);
        for (int i = (F.vcu * NWAVES * 64) + F.tid; i < 2 * RMAX; i += F.G * NWAVES * 64) rt[i] = -1;
    }
}
__device__ __forceinline__ void phase_conv(const Frame& F, ArgsP a, const float* convw  ) {
    if (F.vcu < BATCH * NH) {
        const int b = F.vcu >> 3, h = F.vcu & 7; const float* lf = (const float*)(a->ws + WS_LOGF) + ((size_t)b * SEQ) * 8 + h; float* cb = (float*)(a->ws + WS_CB) + (size_t)F.vcu * SEQ;
        LAS float* wt = (LAS float*)F.lds;
        float v[32]; float run = 0.f;
#pragma unroll
        for (int i = 0; i < 32; ++i) { run += lf[(size_t)(F.tid * 32 + i) * 8]; v[i] = run; }
        float inc = run;
#pragma unroll
        for (int o = 1; o < 64; o <<= 1) { const float t = __int_as_float(__builtin_amdgcn_ds_bpermute(((F.lane - o) & 63) << 2, __float_as_int(inc))); if (F.lane >= o) inc += t; }
        if (F.lane == 63) wt[F.wave] = inc;
        __syncthreads();
        float base = inc - run;
        for (int w = 0; w < F.wave; ++w) base += wt[w];
#pragma unroll
        for (int i = 0; i < 32; ++i) cb[F.tid * 32 + i] = base + v[i];
        __syncthreads();
    }
    bf16* Bz = (bf16*)(a->ws + WS_P6); const bf16* Cb = Bz + (size_t)MTOK * 1024; const bf16* Ub = Bz + (size_t)2 * MTOK * 1024;
    const int gw = F.vcu * NWAVES + F.wave, NGW = F.G * NWAVES;
    for (int it = gw; it < (MTOK / 32) * 2; it += NGW) {
        const int hf = it & 1, t0 = (it >> 1) * 32, c0 = hf * 512 + F.lane * 8;
        float w0[8], w1[8], w2[8];
#pragma unroll
        for (int i = 0; i < 8; ++i) { w0[i] = convw[c0 + i]; w1[i] = convw[1024 + c0 + i]; w2[i] = convw[2048 + c0 + i]; }
        float p2[8], p1[8];
        const bool first = (t0 % SEQ) == 0;
        { v4u cw = {0u, 0u, 0u, 0u}, uw = cw, cw1 = cw, uw1 = cw;
          if (!first) { cw = *(const GAS v4u*)(Cb + (size_t)(t0 - 2) * 1024 + c0); uw = *(const GAS v4u*)(Ub + (size_t)(t0 - 2) * 1024 + c0);
                        cw1 = *(const GAS v4u*)(Cb + (size_t)(t0 - 1) * 1024 + c0); uw1 = *(const GAS v4u*)(Ub + (size_t)(t0 - 1) * 1024 + c0); }
          const unsigned cc[4] = {cw.x, cw.y, cw.z, cw.w}, uu[4] = {uw.x, uw.y, uw.z, uw.w}, cc1[4] = {cw1.x, cw1.y, cw1.z, cw1.w}, uu1[4] = {uw1.x, uw1.y, uw1.z, uw1.w};
#pragma unroll
          for (int q = 0; q < 4; ++q) { p2[2 * q] = pg8::bf_lo(cc[q]) * pg8::bf_lo(uu[q]); p2[2 * q + 1] = pg8::bf_hi(cc[q]) * pg8::bf_hi(uu[q]);
                                        p1[2 * q] = pg8::bf_lo(cc1[q]) * pg8::bf_lo(uu1[q]); p1[2 * q + 1] = pg8::bf_hi(cc1[q]) * pg8::bf_hi(uu1[q]); } }
#pragma unroll 4
        for (int i = 0; i < 32; ++i) { const size_t o = (size_t)(t0 + i) * 1024 + c0;
            const v4u cw = *(const GAS v4u*)(Cb + o), uw = *(const GAS v4u*)(Ub + o), bw = *(const GAS v4u*)(Bz + o);
            const unsigned cc[4] = {cw.x, cw.y, cw.z, cw.w}, uu[4] = {uw.x, uw.y, uw.z, uw.w}, bq[4] = {bw.x, bw.y, bw.z, bw.w}; float cur[8], z[8];
#pragma unroll
            for (int q = 0; q < 4; ++q) { cur[2 * q] = pg8::bf_lo(cc[q]) * pg8::bf_lo(uu[q]); cur[2 * q + 1] = pg8::bf_hi(cc[q]) * pg8::bf_hi(uu[q]); }
#pragma unroll
            for (int q = 0; q < 4; ++q) { z[2 * q] = pg8::bf_lo(bq[q]) * (w0[2 * q] * p2[2 * q] + w1[2 * q] * p1[2 * q] + w2[2 * q] * cur[2 * q]);
                                          z[2 * q + 1] = pg8::bf_hi(bq[q]) * (w0[2 * q + 1] * p2[2 * q + 1] + w1[2 * q + 1] * p1[2 * q + 1] + w2[2 * q + 1] * cur[2 * q + 1]); }
            v4u ow; ow.x = pk2(z[0], z[1]); ow.y = pk2(z[2], z[3]); ow.z = pk2(z[4], z[5]); ow.w = pk2(z[6], z[7]);
            *(GAS v4u*)(Bz + o) = ow;
#pragma unroll
            for (int q = 0; q < 8; ++q) { p2[q] = p1[q]; p1[q] = cur[q]; } }
    }
}
__device__ __forceinline__ fox::BlockRef<fox::bf16, fox::bf16> fox_ref(ArgsP a, int bh, int qb) {
    fox::bf16* P6 = (fox::bf16*)(a->ws + WS_P6); const int b = bh >> 3, h = bh & 7; const size_t base = (size_t)b * SEQ * 1024 + h * 128;
    fox::BlockRef<fox::bf16, fox::bf16> r;
    r.Q = P6 + (size_t)3 * MTOK * 1024 + base + (size_t)qb * 256 * 1024; r.O = (fox::bf16*)r.Q;
    r.K = P6 + (size_t)4 * MTOK * 1024 + base; r.V = P6 + (size_t)5 * MTOK * 1024 + base;
    r.cb = (const float*)(a->ws + WS_CB) + (size_t)bh * SEQ; r.P0 = qb * 256; r.cref = r.cb[r.P0]; r.jlo = 0;
    return r;
}
__device__ __forceinline__ void phase_attn(const Frame& F, ArgsP a, char* lds) {
    constexpr int NQB = SEQ / 256, NX = NQB / 2, TOTAL = BATCH * NH * NX;
    int L = F.vcu; if (L >= TOTAL) return;
    int pass = 0;
    fox::BlockRef<fox::bf16, fox::bf16> cur = fox_ref(a, L / NX, L % NX);
    fox::Seam<fox::bf16> S;
    fox::causal_swa_prime<fox::bf16, fox::bf16>(cur, SEQ, lds, S);
    for (;;) {
        const bool more_pass = pass == 0, more_item = L + F.G < TOTAL, last = !more_pass && !more_item;
        int passn = pass + 1, Ln = L;
        if (!more_pass) { passn = 0; Ln = more_item ? L + F.G : L; }
        const int xn = Ln % NX;
        const fox::BlockRef<fox::bf16, fox::bf16> nxt = last ? cur : fox_ref(a, Ln / NX, passn ? NQB - 1 - xn : xn);
        fox::causal_swa_block<fox::bf16, fox::bf16>(cur, nxt, SEQ, SEQ, lds, S);
        if (last) break;
        cur = nxt; pass = passn; L = Ln;
    }
}
struct MoeLayout { int base[8]; int ntiles; };
__device__ __forceinline__ void moe_layout(ArgsP a, int rank, MoeLayout& ml) {
    const unsigned* cnt = (const unsigned*)a->ws + CW_CNT + rank * 8; int run = 0;
#pragma unroll
    for (int e = 0; e < 8; ++e) { ml.base[e] = run; run += ((int)cnt[e] + 255) & ~255; }
    ml.ntiles = run >> 8;
}
__device__ __forceinline__ void moe_tile_table(const Frame& F, ArgsP a, int rank, int& ntiles) {
    MoeLayout ml; moe_layout(a, rank, ml); ntiles = ml.ntiles;
    LAS int* te = (LAS int*)(F.lds + TILE_E_OFF);
    for (int t = F.tid; t < 160; t += NWAVES * 64) { int e = 0;
#pragma unroll
        for (int q = 1; q < 8; ++q) e += (t * 256 >= ml.base[q]) ? 1 : 0;
        te[t] = e; }
    __syncthreads();
}
__device__ __forceinline__ void gather_row(const bf16* src, bf16* dst, int lane) {
    const GAS v4u* s = (const GAS v4u*)src + lane; GAS v4u* d = (GAS v4u*)dst + lane;
    const v4u a0 = s[0], a1 = s[64], a2 = s[128], a3 = s[192]; d[0] = a0; d[64] = a1; d[128] = a2; d[192] = a3;
}
__device__ __forceinline__ void phase_route(const Frame& F, ArgsP a) {
    MoeLayout ml0, ml1; moe_layout(a, 0, ml0); moe_layout(a, 1, ml1);
    const int* tokE = (const int*)(a->ws + WS_TOKE); const float* tokW = (const float*)(a->ws + WS_TOKW);
    int* rowtok = (int*)(a->ws + WS_ROWTOK); float* roww = (float*)(a->ws + WS_ROWW); unsigned* cur = (unsigned*)a->ws + CW_CUR;
    const bf16* A2 = (const bf16*)(a->ws + WS_A); bf16* XG = (bf16*)(a->ws + WS_XG);
    const int gw = F.vcu * NWAVES + F.wave, NGW = F.G * NWAVES;
    for (int t0 = gw * 16; t0 < MTOK; t0 += NGW * 16) {
        const bool act = F.lane < 16; const int t = t0 + (F.lane & 15);
        int pos0 = 0;
#pragma unroll
        for (int rank = 0; rank < 2; ++rank) {
            const int e = act ? tokE[2 * t + rank] : -1; const float w = act ? tokW[2 * t + rank] : 0.f; int pos = -1;
#pragma unroll
            for (int q = 0; q < 8; ++q) { const unsigned long long m = __ballot(e == q);
                if (m) { unsigned b0 = 0; if (F.lane == 0) b0 = __hip_atomic_fetch_add(cur + rank * 8 + q, (unsigned)__popcll(m), __ATOMIC_RELAXED, __HIP_MEMORY_SCOPE_AGENT);
                    b0 = __builtin_amdgcn_readfirstlane(b0);
                    if (e == q) pos = (rank ? ml1.base[q] : ml0.base[q]) + (int)b0 + __popcll(m & ((1ull << F.lane) - 1ull)); } }
            if (act) { rowtok[rank * RMAX + pos] = t; roww[rank * RMAX + pos] = w; }
            if (rank == 0) pos0 = pos;
        }
        for (int i = 0; i < 16; ++i) { const int p = __builtin_amdgcn_readlane(pos0, i); gather_row(A2 + (size_t)(t0 + i) * DM, XG + (size_t)p * DM, F.lane); }
    }
}
__device__ __forceinline__ void phase_gather(const Frame& F, ArgsP a, int rank) {
    MoeLayout ml; moe_layout(a, rank, ml);
    const int* rowtok = (const int*)(a->ws + WS_ROWTOK) + rank * RMAX; const bf16* A2 = (const bf16*)(a->ws + WS_A); bf16* XG = (bf16*)(a->ws + WS_XG);
    const int gw = F.vcu * NWAVES + F.wave, NGW = F.G * NWAVES, nrows = ml.ntiles * 256;
    for (int p = gw; p < nrows; p += NGW) { const int t = rowtok[p]; if (t >= 0) gather_row(A2 + (size_t)t * DM, XG + (size_t)p * DM, F.lane); }
}

__global__ void __launch_bounds__(NWAVES * 64, 2) fwd(Args args) {
    extern __shared__ __attribute__((aligned(16))) unsigned char lds_raw[];
    { const int t0 = threadIdx.x; for (int u = t0; u < (LDS_BYTES - LDSCTL_OFF) / 4; u += NWAVES * 64) ((LAS unsigned*)((LAS unsigned char*)lds_raw + LDSCTL_OFF))[u] = 0u; }
    __syncthreads();
    (void)xcd_barrier_post((unsigned*)args.ws + CW_BAR, (volatile LAS unsigned*)((LAS unsigned char*)lds_raw + MISC_OFF) + 8);
    const int lo = args.ph_lo, hi = args.ph_hi; int ph = 0;
#define PH_ON (ph >= lo && ph < hi)
#define PH_SEAM() do { if (ph + 1 < hi) { XcdBarrier b2; b2.bar = (unsigned*)ws + CW_BAR; b2.x = xb_xcc_id(); b2.st = (volatile LAS unsigned*)((LAS unsigned char*)lds_raw + MISC_OFF) + 8; xcd_barrier(b2); } } while (0)
#define PH_FRAME() Frame F; F.lds = (LAS unsigned char*)lds_raw; F.tid = pg8::opaque_tid(); F.lane = F.tid & 63; F.wave = __builtin_amdgcn_readfirstlane(F.tid >> 6); \
    F.G = gridDim.x; { const int bx = blockIdx.x; F.vcu = (F.G % 8 == 0) ? (bx % 8) * (F.G / 8) + bx / 8 : bx; } \
    ArgsP A = (ArgsP)__builtin_amdgcn_kernarg_segment_ptr(); asm volatile("" : "+s"(A)); unsigned char* ws = A->ws; float* const out = A->out; (void)out; \
    bf16* const A_ = (bf16*)(ws + WS_A); bf16* const P6_ = (bf16*)(ws + WS_P6); bf16* const G_ = (bf16*)(ws + WS_G); (void)A_; (void)P6_; (void)G_

    if (PH_ON) { PH_FRAME(); phase_convert(F, A); PH_SEAM(); } ++ph;

    for (int layer = 0; layer < 2; ++layer) {

        if (PH_ON) { PH_FRAME(); phase_norm<0>(F, A, layer == 0 ? A->in[I_X] : (const float*)out, A->in[I_MIXN] + layer * DM, A_, nullptr, A->in[I_WIN] + (size_t)layer * DM * PTOT + 6144, PTOT, A->in[I_BF] + layer * 8); PH_SEAM(); } ++ph;
        if (PH_ON) { PH_FRAME(); pg8::Gemm g{A_, (const bf16*)(ws + WS_WIN) + (size_t)layer * NPROJ * DM, MTOK, NPROJ, DM}; pg8::StaticOrder S; S.init(MTOK, NPROJ, F.G, (int)blockIdx.x);
            pg8::EpiInProj E{P6_, G_, MTOK};
            pg8::gemm_phase<pg8::EpiInProj, pg8::StaticOrder, true, true>(F.lds, g, S, E); PH_SEAM(); } ++ph;
        if (PH_ON) { PH_FRAME(); phase_conv(F, A, A->in[I_CONVW] + layer * 3 * DCONV); PH_SEAM(); } ++ph;
        if (PH_ON) { { PH_FRAME(); phase_attn(F, A, (char*)lds_raw); }
            PH_FRAME(); pg8::Gemm g{P6_, (const bf16*)(ws + WS_WCO) + (size_t)layer * DM * 1024, MTOK, DM, 1024}; pg8::StaticOrder S; S.init(MTOK, DM, F.G, (int)blockIdx.x);
            pg8::EpiMerge<0> E{G_, A_};
            pg8::gemm_phase<pg8::EpiMerge<0>, pg8::StaticOrder, true, true>(F.lds, g, S, E); PH_SEAM(); } ++ph;
        if (PH_ON) { PH_FRAME(); pg8::Gemm g{P6_ + (size_t)3 * MTOK * 1024, (const bf16*)(ws + WS_WAO) + (size_t)layer * DM * 1024, MTOK, DM, 1024}; pg8::StaticOrder S; S.init(MTOK, DM, F.G, (int)blockIdx.x);
            pg8::EpiMerge<1> E{G_ + 2048, A_};
            pg8::gemm_phase<pg8::EpiMerge<1>, pg8::StaticOrder, true, true>(F.lds, g, S, E); PH_SEAM(); } ++ph;
        if (PH_ON) { PH_FRAME(); pg8::Gemm g{A_, (const bf16*)(ws + WS_WO) + (size_t)layer * DM * DM, MTOK, DM, DM}; pg8::StaticOrder S; S.init(MTOK, DM, F.G, (int)blockIdx.x);
            pg8::EpiResid E{layer == 0 ? A->in[I_X] : (const float*)out, out};
            pg8::gemm_phase<pg8::EpiResid, pg8::StaticOrder, true, true>(F.lds, g, S, E); PH_SEAM(); } ++ph;
        if (layer == 0) {
            if (PH_ON) { PH_FRAME(); phase_norm<1>(F, A, out, A->in[I_FFNN], A_, nullptr, nullptr, 0, nullptr); PH_SEAM(); } ++ph;
            if (PH_ON) { PH_FRAME(); pg8::Gemm g{A_, (const bf16*)(ws + WS_WGU), MTOK, 2 * DFF, DM}; pg8::StaticOrder S; S.init(MTOK, 2 * DFF, F.G, (int)blockIdx.x);
                pg8::EpiSwiGLU E{(bf16*)(ws + WS_HID), DFF};
                pg8::gemm_phase<pg8::EpiSwiGLU, pg8::StaticOrder, true, true>(F.lds, g, S, E); PH_SEAM(); } ++ph;
            if (PH_ON) { PH_FRAME(); pg8::Gemm g{(const bf16*)(ws + WS_HID), (const bf16*)(ws + WS_WDD), MTOK, DM, DFF}; pg8::StaticOrder S; S.init(MTOK, DM, F.G, (int)blockIdx.x);
                pg8::EpiResid E{out, out};
                pg8::gemm_phase<pg8::EpiResid, pg8::StaticOrder, true, true>(F.lds, g, S, E); PH_SEAM(); } ++ph;
        } else {
            if (PH_ON) { PH_FRAME(); phase_norm<2>(F, A, out, A->in[I_FFNN] + DM, A_, nullptr, A->in[I_RW], 8, A->in[I_RB]); PH_SEAM(); } ++ph;
            if (PH_ON) { PH_FRAME(); phase_route(F, A); PH_SEAM(); } ++ph;
            for (int rank = 0; rank < 2; ++rank) {
                if (rank == 1) { if (PH_ON) { PH_FRAME(); phase_gather(F, A, 1); PH_SEAM(); } ++ph; }
                if (PH_ON) { PH_FRAME(); int nt; moe_tile_table(F, A, rank, nt);
                    pg8::Gemm g{(const bf16*)(ws + WS_XG), (const bf16*)(ws + WS_MWGU), nt * 256, 2 * DFFE, DM}; pg8::MoeOrder S; S.init(nt * 256, 2 * DFFE, F.G, (int)blockIdx.x);
                    S.tile_e = (const LAS int*)(F.lds + TILE_E_OFF); S.estride = (size_t)2 * DFFE * DM * 2;
                    pg8::EpiSwiGLU E{(bf16*)(ws + WS_HID), DFFE};
                    pg8::gemm_phase<pg8::EpiSwiGLU, pg8::MoeOrder, true, true>(F.lds, g, S, E); PH_SEAM(); } ++ph;
                if (PH_ON) { PH_FRAME(); int nt; moe_tile_table(F, A, rank, nt);
                    pg8::Gemm g{(const bf16*)(ws + WS_HID), (const bf16*)(ws + WS_MWD), nt * 256, DM, DFFE}; pg8::MoeOrder S; S.init(nt * 256, DM, F.G, (int)blockIdx.x);
                    S.tile_e = (const LAS int*)(F.lds + TILE_E_OFF); S.estride = (size_t)DM * DFFE * 2;
                    pg8::EpiMoeDown E{(const int*)(ws + WS_ROWTOK) + rank * RMAX, (const float*)(ws + WS_ROWW) + rank * RMAX, out};
                    pg8::gemm_phase<pg8::EpiMoeDown, pg8::MoeOrder, true, true>(F.lds, g, S, E); PH_SEAM(); } ++ph;
            }
        }
    }
    if (PH_ON) { PH_FRAME(); phase_norm<3>(F, A, out, A->in[I_FN], nullptr, out, nullptr, 0, nullptr); } ++ph;
#undef PH_ON
#undef PH_SEAM
#undef PH_FRAME
}
constexpr int N_PHASES = 1 + 6 + 3 + 6 + 2 + 1 + 2 * 2 + 1;

extern "C" void kernel_launch(void* const* d_in, const int* in_sizes, int n_in, void* d_out, int out_size, void* d_ws, size_t ws_size, hipStream_t stream) {
    static int grid = 0;
    if (grid == 0) {
        if (n_in != N_IN || in_sizes[0] != MTOK * DM || out_size != MTOK * DM || ws_size < WS_END) { fprintf(stderr, "kernel_launch: shape/workspace mismatch (n_in %d, ws %zu, need %zu); nothing launched\n", n_in, ws_size, (size_t)WS_END); grid = -1; return; }
        int dev = 0, cus = 0, per_cu = 0;
        if (hipGetDevice(&dev) != hipSuccess || hipDeviceGetAttribute(&cus, hipDeviceAttributeMultiprocessorCount, dev) != hipSuccess) { grid = -1; return; }
        if (hipFuncSetAttribute((const void*)fwd, hipFuncAttributeMaxDynamicSharedMemorySize, LDS_BYTES) != hipSuccess) { fprintf(stderr, "kernel_launch: hipFuncSetAttribute failed\n"); grid = -1; return; }
        if (hipOccupancyMaxActiveBlocksPerMultiprocessor(&per_cu, (const void*)fwd, NWAVES * 64, LDS_BYTES) != hipSuccess || per_cu < 1) { fprintf(stderr, "kernel_launch: occupancy query says %d\n", per_cu); grid = -1; (void)hipGetLastError(); return; }
        grid = cus;
        if (MTOK % (grid * NWAVES) != 0) { fprintf(stderr, "kernel_launch: grid %d does not divide the token rows\n", grid); grid = -1; return; }
    }
    if (grid < 0) return;
    if (hipMemsetAsync((char*)d_ws + WS_CTL, 0, CTL_ZERO_BYTES, stream) != hipSuccess) return;
    Args ka; memset(&ka, 0, sizeof(ka));
    for (int i = 0; i < N_IN; ++i) ka.in[i] = (const float*)d_in[i];
    ka.out = (float*)d_out; ka.ws = (unsigned char*)d_ws;
#if MK_PER_PHASE
    for (int p = 0; p < N_PHASES; ++p) { ka.ph_lo = p; ka.ph_hi = p + 1; hipLaunchKernelGGL(fwd, dim3(grid), dim3(NWAVES * 64), LDS_BYTES, stream, ka); }
#else
    ka.ph_lo = 0; ka.ph_hi = N_PHASES; hipLaunchKernelGGL(fwd, dim3(grid), dim3(NWAVES * 64), LDS_BYTES, stream, ka);
#endif
}
```

```cpp
#include <hip/hip_runtime.h>
#include <cstdio>
#include <cstdint>
#include <cstring>
namespace pg8 {
#define PG8_LAS __attribute__((address_space(3)))
typedef unsigned short bf16_t;
typedef short bf16x8 __attribute__((ext_vector_type(8)));
typedef float f32x4 __attribute__((ext_vector_type(4)));
typedef unsigned u32x4 __attribute__((ext_vector_type(4)));
constexpr int BM = 256, BK = 64, HALF = 128, HTB = HALF * BK * 2  , STAGE_BYTES = 8 * HTB, NXCD = 8, WGM = 8;

__host__ __device__ __forceinline__ int lds_byte(int r, int c) { const int st = (r >> 4) * 2 + (c >> 5), rr = r & 15, cc = c & 31, ob = rr * 64 + cc * 2; return st * 1024 + (ob ^ (((ob >> 9) & 1) << 5)); }
__host__ __device__ __forceinline__ void stage_rc(int b, int& R, int& C) { const int st = b / 1024, sb = b % 1024, swz = sb ^ (((sb >> 9) & 1) << 5); R = (st >> 1) * 16 + swz / 64; C = (st & 1) * 32 + (swz % 64) / 2; }
__host__ __device__ __forceinline__ int perm32(int rho) { const int n = rho >> 4, i = rho & 15; return 8 * (i >> 2) + 4 * n + (i & 3); }

__device__ __forceinline__ int opaque_tid() { int t = (int)threadIdx.x; asm volatile("" : "+v"(t)); return t; }
struct Unit { int pm, pn; };
struct Gemm { const bf16_t* A; const bf16_t* Bt; int M, N, K; };

struct StaticOrder {
    int nM, nN, nwg, G, c;
    __host__ __device__ void init(int M, int N, int G_, int c_) { nM = M / BM; nN = N / BM; nwg = nM * nN; G = G_; c = c_; }
    __host__ __device__ bool next(int i, Unit& u) const {
        const long L = (long)i * G + c; if (L >= nwg) return false;
        int wgid = (int)L; { const int q = nwg / NXCD, r = nwg % NXCD, xcd = wgid % NXCD, off = wgid / NXCD; wgid = (xcd < r ? xcd * (q + 1) : r * (q + 1) + (xcd - r) * q) + off; }
        const int nig = WGM * nN, gid = wgid / nig, fm = gid * WGM, gsz = (nM - fm) < WGM ? (nM - fm) : WGM;
        u.pm = fm + ((wgid % nig) % gsz); u.pn = (wgid % nig) / gsz; return true;
    }
    __device__ __forceinline__ void a_ready(const Unit&) const {}
    __device__ __forceinline__ void done(const Unit&) const {}
    __device__ __forceinline__ const char* bbase(const Gemm& g, const Unit&) const { return (const char*)g.Bt; }
};
__device__ __forceinline__ unsigned cvt_pk_bf16(float lo, float hi) { unsigned r; asm volatile("v_cvt_pk_bf16_f32 %0, %1, %2" : "=v"(r) : "v"(lo), "v"(hi)); return r; }
typedef float f32x2 __attribute__((ext_vector_type(2)));
__device__ __forceinline__ float sigm(float x) { return __builtin_amdgcn_rcpf(1.0f + __builtin_amdgcn_exp2f(-1.4426950408889634f * x)); }
__device__ __forceinline__ float bf_lo(unsigned w) { return __uint_as_float(w << 16); }
__device__ __forceinline__ float bf_hi(unsigned w) { return __uint_as_float(w & 0xffff0000u); }

struct EpiInProj {
    static constexpr bool PERM = true, AFTER_DRAIN = false;
    bf16_t* P6; bf16_t* Gt; int M;
    __device__ __forceinline__ void operator()(const f32x4 (&acc)[2][2][4][2], const Unit& u, int wr, int wc, int fr, int fq) const {
        const int row0 = u.pm * BM + wr * 64 + fr; const int colt = u.pn * BM; const int t = colt >> 10; const bool gate = t >= 6;
        bf16_t* base = gate ? Gt + (colt - 6144) : P6 + (size_t)t * M * 1024 + (colt & 1023);
        const int ldc = gate ? 4096 : 1024; const int col0 = wc * 32 + 8 * fq;
#pragma unroll
        for (int ai = 0; ai < 2; ++ai)
#pragma unroll
            for (int m = 0; m < 4; ++m) { bf16_t* rowp = base + (size_t)(row0 + ai * HALF + m * 16) * ldc + col0;
#pragma unroll
                for (int bj = 0; bj < 2; ++bj) { f32x4 v0 = acc[ai][bj][m][0], v1 = acc[ai][bj][m][1];
                    if (gate) {
#pragma unroll
                        for (int j = 0; j < 4; ++j) { v0[j] = sigm(v0[j]); v1[j] = sigm(v1[j]); } }
                    u32x4 w; w.x = cvt_pk_bf16(v0[0], v0[1]); w.y = cvt_pk_bf16(v0[2], v0[3]); w.z = cvt_pk_bf16(v1[0], v1[1]); w.w = cvt_pk_bf16(v1[2], v1[3]);
                    *(u32x4*)(rowp + bj * HALF) = w; } }
    }
};
template <int MODE> struct EpiMerge {
    static constexpr bool PERM = true, AFTER_DRAIN = false;
    const bf16_t* Gt; bf16_t* Mb;
    __device__ __forceinline__ void operator()(const f32x4 (&acc)[2][2][4][2], const Unit& u, int wr, int wc, int fr, int fq) const {
        const int row0 = u.pm * BM + wr * 64 + fr; const int col0 = u.pn * BM + wc * 32 + 8 * fq;
#pragma unroll
        for (int ai = 0; ai < 2; ++ai)
#pragma unroll
            for (int m = 0; m < 4; ++m) { const size_t r = (size_t)(row0 + ai * HALF + m * 16); const bf16_t* gp = Gt + r * 4096 + col0; bf16_t* mp = Mb + r * 2048 + col0;
#pragma unroll
                for (int bj = 0; bj < 2; ++bj) { const u32x4 gw = *(const u32x4*)(gp + bj * HALF); const f32x4 a0 = acc[ai][bj][m][0], a1 = acc[ai][bj][m][1];
                    f32x4 v0, v1;
                    v0[0] = bf_lo(gw.x) * a0[0]; v0[1] = bf_hi(gw.x) * a0[1]; v0[2] = bf_lo(gw.y) * a0[2]; v0[3] = bf_hi(gw.y) * a0[3];
                    v1[0] = bf_lo(gw.z) * a1[0]; v1[1] = bf_hi(gw.z) * a1[1]; v1[2] = bf_lo(gw.w) * a1[2]; v1[3] = bf_hi(gw.w) * a1[3];
                    if (MODE == 1) { const u32x4 mw = *(const u32x4*)(mp + bj * HALF);
                        v0[0] += bf_lo(mw.x); v0[1] += bf_hi(mw.x); v0[2] += bf_lo(mw.y); v0[3] += bf_hi(mw.y);
                        v1[0] += bf_lo(mw.z); v1[1] += bf_hi(mw.z); v1[2] += bf_lo(mw.w); v1[3] += bf_hi(mw.w); }
                    u32x4 w; w.x = cvt_pk_bf16(v0[0], v0[1]); w.y = cvt_pk_bf16(v0[2], v0[3]); w.z = cvt_pk_bf16(v1[0], v1[1]); w.w = cvt_pk_bf16(v1[2], v1[3]);
                    *(u32x4*)(mp + bj * HALF) = w; } }
    }
};
struct EpiResid {
    static constexpr bool PERM = false, AFTER_DRAIN = false;
    const float* base; float* out;
    __device__ __forceinline__ void operator()(const f32x4 (&acc)[2][2][4][2], const Unit& u, int wr, int wc, int fr, int fq) const {
        const int row0 = u.pm * BM + wr * 64 + fr, col0 = u.pn * BM + wc * 32 + 4 * fq;
#pragma unroll
        for (int ai = 0; ai < 2; ++ai)
#pragma unroll
            for (int m = 0; m < 4; ++m) { const size_t off = (size_t)(row0 + ai * HALF + m * 16) * 2048 + col0;
#pragma unroll
                for (int bj = 0; bj < 2; ++bj)
#pragma unroll
                    for (int n = 0; n < 2; ++n) { const f32x4 bs = *(const f32x4*)(base + off + bj * HALF + n * 16); *(f32x4*)(out + off + bj * HALF + n * 16) = bs + acc[ai][bj][m][n]; }
                asm volatile("" ::: "memory"); }
    }
};
struct EpiSwiGLU {
    static constexpr bool PERM = true, AFTER_DRAIN = false;
    bf16_t* H; int ldh;
    __device__ __forceinline__ void operator()(const f32x4 (&acc)[2][2][4][2], const Unit& u, int wr, int wc, int fr, int fq) const {
        const int row0 = u.pm * BM + wr * 64 + fr; const int col0 = u.pn * HALF + wc * 32 + 8 * fq;
#pragma unroll
        for (int ai = 0; ai < 2; ++ai)
#pragma unroll
            for (int m = 0; m < 4; ++m) { bf16_t* rowp = H + (size_t)(row0 + ai * HALF + m * 16) * ldh + col0;
                const f32x4 g0 = acc[ai][0][m][0], g1 = acc[ai][0][m][1], u0 = acc[ai][1][m][0], u1 = acc[ai][1][m][1]; f32x4 v0, v1;
#pragma unroll
                for (int j = 0; j < 4; ++j) { v0[j] = g0[j] * sigm(g0[j]) * u0[j]; v1[j] = g1[j] * sigm(g1[j]) * u1[j]; }
                u32x4 w; w.x = cvt_pk_bf16(v0[0], v0[1]); w.y = cvt_pk_bf16(v0[2], v0[3]); w.z = cvt_pk_bf16(v1[0], v1[1]); w.w = cvt_pk_bf16(v1[2], v1[3]);
                *(u32x4*)rowp = w; }
    }
};
struct EpiMoeDown {
    static constexpr bool PERM = false, AFTER_DRAIN = false;
    const int* row_tok; const float* row_w; float* h;
    __device__ __forceinline__ void operator()(const f32x4 (&acc)[2][2][4][2], const Unit& u, int wr, int wc, int fr, int fq) const {
        const int rloc = u.pm * BM + wr * 64 + fr, col0 = u.pn * BM + wc * 32 + 4 * fq;
#pragma unroll
        for (int ai = 0; ai < 2; ++ai)
#pragma unroll
            for (int m = 0; m < 4; ++m) { const int r = rloc + ai * HALF + m * 16; const int tok = row_tok[r]; const float w = row_w[r];
                if (tok >= 0) { float* p = h + (size_t)tok * 2048 + col0;
#pragma unroll
                    for (int bj = 0; bj < 2; ++bj)
#pragma unroll
                        for (int n = 0; n < 2; ++n) { const f32x4 bs = *(const f32x4*)(p + bj * HALF + n * 16); *(f32x4*)(p + bj * HALF + n * 16) = bs + w * acc[ai][bj][m][n]; } }
                asm volatile("" ::: "memory"); }
    }
};
struct MoeOrder : StaticOrder {
    const PG8_LAS int* tile_e; size_t estride;
    __device__ __forceinline__ const char* bbase(const Gemm& g, const Unit& u) const { return (const char*)g.Bt + (size_t)__builtin_amdgcn_readfirstlane(tile_e[u.pm]) * estride; }
};
template <class Epi, class Sched, bool ALIGN_EPI = false, bool SP2 = false>
__device__ __forceinline__ void gemm_phase(PG8_LAS unsigned char* lds, const Gemm g, const Sched& S, const Epi& E) {
    const int tid = opaque_tid(), wid = __builtin_amdgcn_readfirstlane(tid >> 6), lane = tid & 63, wr = wid >> 2, wc = wid & 3, fr = lane & 15, fq = lane >> 4;
    const int K = g.K, nt = K / BK;
    unsigned voffA[2], voffB[2];
#pragma unroll
    for (int i = 0; i < 2; ++i) { int R, C; stage_rc(tid * 16 + i * 8192, R, C); const int Rb = Epi::PERM ? ((R & ~31) + perm32(R & 31)) : R;
        voffA[i] = (unsigned)(R * K + C) * 2u; voffB[i] = (unsigned)(Rb * K + C) * 2u; }
    const size_t kstep = (size_t)(BK * 2);
    const size_t hstep = (size_t)HALF * K * 2;
    const size_t tstep = 2 * hstep;
    const unsigned ldsw = (unsigned)wid * 1024u;
    const int aoff = lds_byte(wr * 64 + fr, fq * 8), boff = lds_byte(wc * 32 + fr, fq * 8);
#define PG8_SA(b, h) (((b) * 2 + (h)) * HTB)
#define PG8_SB(b, h) ((4 + (b) * 2 + (h)) * HTB)
#define PG8_STAGE(bufoff, gbase, voff) do { _Pragma("unroll") for (int _i = 0; _i < 2; ++_i) \
        __builtin_amdgcn_global_load_lds((const unsigned*)((const char*)(gbase) + (voff)[_i]), (PG8_LAS unsigned*)(lds + (bufoff) + ldsw + _i * 8192), 16, 0, 0); } while (0)
#define PG8_LDA(dst, b, h) do { _Pragma("unroll") for (int m = 0; m < 4; ++m) _Pragma("unroll") for (int k = 0; k < 2; ++k) dst[m][k] = *(const PG8_LAS bf16x8*)(lds + PG8_SA(b, h) + aoff + m * 2048 + k * 1024); } while (0)
#define PG8_LDB(dst, b, h) do { _Pragma("unroll") for (int n = 0; n < 2; ++n) _Pragma("unroll") for (int k = 0; k < 2; ++k) dst[n][k] = *(const PG8_LAS bf16x8*)(lds + PG8_SB(b, h) + boff + n * 2048 + k * 1024); } while (0)
#define PG8_MMA(ai, bj, At, Bt) do { __builtin_amdgcn_s_setprio(1); _Pragma("unroll") for (int m = 0; m < 4; ++m) _Pragma("unroll") for (int n = 0; n < 2; ++n) _Pragma("unroll") for (int k = 0; k < 2; ++k) \
        acc[ai][bj][m][n] = __builtin_amdgcn_mfma_f32_16x16x32_bf16(Bt[n][k], At[m][k], acc[ai][bj][m][n], 0, 0, 0); __builtin_amdgcn_s_setprio(0); } while (0)
#define PG8_WAIT_V(n) asm volatile("s_waitcnt vmcnt(" #n ")" ::: "memory")
#define PG8_WAIT_L(n) asm volatile("s_waitcnt lgkmcnt(" #n ")" ::: "memory")
#define PG8_BAR __builtin_amdgcn_s_barrier()
#define PG8_SCHED __builtin_amdgcn_sched_barrier(0)
    Unit cur, nxt; int ui = 0;
    if (!S.next(0, cur)) return;
    f32x4 acc[2][2][4][2];
#pragma unroll
    for (int a = 0; a < 2; ++a)
#pragma unroll
        for (int b = 0; b < 2; ++b)
#pragma unroll
            for (int m = 0; m < 4; ++m)
#pragma unroll
                for (int n = 0; n < 2; ++n) acc[a][b][m][n] = (f32x4){0.f, 0.f, 0.f, 0.f};
    bf16x8 At[4][2], B0[2][2], B1[2][2];
    const char* cA = (const char*)g.A + (size_t)cur.pm * tstep; const char* cB = S.bbase(g, cur) + (size_t)cur.pn * tstep;
    S.a_ready(cur);
    if constexpr (SP2) {
        PG8_STAGE(PG8_SB(0, 0), cB, voffB); PG8_STAGE(PG8_SB(0, 1), cB + hstep, voffB); PG8_STAGE(PG8_SA(0, 0), cA, voffA); PG8_STAGE(PG8_SA(0, 1), cA + hstep, voffA);
        if (wr == 1) PG8_BAR;
        PG8_WAIT_V(2); PG8_BAR;
        PG8_STAGE(PG8_SB(1, 0), cB + kstep, voffB); PG8_STAGE(PG8_SA(1, 0), cA + kstep, voffA); PG8_STAGE(PG8_SB(1, 1), cB + hstep + kstep, voffB);
        PG8_WAIT_V(6); PG8_BAR;
    } else {
        PG8_STAGE(PG8_SB(0, 0), cB, voffB); PG8_STAGE(PG8_SA(0, 0), cA, voffA); PG8_STAGE(PG8_SB(0, 1), cB + hstep, voffB); PG8_STAGE(PG8_SA(0, 1), cA + hstep, voffA);
        if (wr == 1) PG8_BAR;
        PG8_WAIT_V(4); PG8_BAR;
        PG8_STAGE(PG8_SB(1, 0), cB + kstep, voffB); PG8_STAGE(PG8_SA(1, 0), cA + kstep, voffA); PG8_STAGE(PG8_SB(1, 1), cB + hstep + kstep, voffB);
        PG8_WAIT_V(6); PG8_BAR;
    }
    for (;;) {
        const bool has_next = S.next(ui + 1, nxt);
        const char* nA = has_next ? (const char*)g.A + (size_t)nxt.pm * tstep : cA; const char* nB = has_next ? S.bbase(g, nxt) + (size_t)nxt.pn * tstep : cB;
        for (int t = 0; t < nt; t += 2) {
            const bool last = (t == nt - 2);
            const char* a1 = cA + (size_t)(t + 1) * kstep;
            const char* a2 = last ? nA : cA + (size_t)(t + 2) * kstep; const char* b2 = last ? nB : cB + (size_t)(t + 2) * kstep;
            const char* a3 = a2 + kstep; const char* b3 = b2 + kstep;
            if (last && has_next) S.a_ready(nxt);
            if constexpr (SP2) {
            PG8_LDB(B0, 0, 0); PG8_LDB(B1, 0, 1); PG8_SCHED; PG8_LDA(At, 0, 0); PG8_STAGE(PG8_SA(1, 1), a1 + hstep, voffA);
            PG8_WAIT_V(8); PG8_WAIT_L(0); PG8_BAR; PG8_MMA(0, 0, At, B0); PG8_MMA(0, 1, At, B1); PG8_BAR; PG8_SCHED;
            PG8_LDA(At, 0, 1); PG8_STAGE(PG8_SB(0, 0), b2, voffB); PG8_STAGE(PG8_SB(0, 1), b2 + hstep, voffB); PG8_STAGE(PG8_SA(0, 0), a2, voffA);
            PG8_WAIT_V(8); PG8_WAIT_L(0); PG8_BAR; PG8_MMA(1, 0, At, B0); PG8_MMA(1, 1, At, B1); PG8_BAR; PG8_SCHED;
            PG8_LDB(B0, 1, 0); PG8_LDB(B1, 1, 1); PG8_SCHED; PG8_LDA(At, 1, 0); PG8_STAGE(PG8_SA(0, 1), a2 + hstep, voffA);
            PG8_WAIT_V(8); PG8_WAIT_L(0); PG8_BAR; PG8_MMA(0, 0, At, B0); PG8_MMA(0, 1, At, B1); PG8_BAR; PG8_SCHED;
            PG8_LDA(At, 1, 1); PG8_STAGE(PG8_SB(1, 0), b3, voffB); PG8_STAGE(PG8_SB(1, 1), b3 + hstep, voffB); PG8_STAGE(PG8_SA(1, 0), a3, voffA);
            PG8_WAIT_V(8); PG8_WAIT_L(0); PG8_BAR; PG8_MMA(1, 0, At, B0); PG8_MMA(1, 1, At, B1); PG8_BAR; PG8_SCHED;
            } else {
            PG8_LDB(B0, 0, 0); PG8_SCHED; PG8_LDA(At, 0, 0); PG8_STAGE(PG8_SA(1, 1), a1 + hstep, voffA);
            PG8_WAIT_L(8); PG8_BAR; PG8_WAIT_L(0); PG8_MMA(0, 0, At, B0); PG8_BAR; PG8_SCHED;
            PG8_LDB(B1, 0, 1); PG8_STAGE(PG8_SB(0, 0), b2, voffB);
            PG8_BAR; PG8_WAIT_L(0); PG8_MMA(0, 1, At, B1); PG8_BAR;
            PG8_LDA(At, 0, 1); PG8_STAGE(PG8_SA(0, 0), a2, voffA);
            PG8_BAR; PG8_WAIT_L(0); PG8_MMA(1, 0, At, B0); PG8_BAR; PG8_SCHED;
            PG8_STAGE(PG8_SB(0, 1), b2 + hstep, voffB);
            PG8_WAIT_V(6); PG8_BAR; PG8_MMA(1, 1, At, B1); PG8_BAR;
            PG8_LDB(B0, 1, 0); PG8_SCHED; PG8_LDA(At, 1, 0); PG8_STAGE(PG8_SA(0, 1), a2 + hstep, voffA);
            PG8_WAIT_L(8); PG8_BAR; PG8_WAIT_L(0); PG8_MMA(0, 0, At, B0); PG8_BAR; PG8_SCHED;
            PG8_LDB(B1, 1, 1); PG8_STAGE(PG8_SB(1, 0), b3, voffB);
            PG8_BAR; PG8_WAIT_L(0); PG8_MMA(0, 1, At, B1); PG8_BAR;
            PG8_LDA(At, 1, 1); PG8_STAGE(PG8_SA(1, 0), a3, voffA);
            PG8_BAR; PG8_WAIT_L(0); PG8_MMA(1, 0, At, B0); PG8_BAR; PG8_SCHED;
            PG8_STAGE(PG8_SB(1, 1), b3 + hstep, voffB);
            PG8_WAIT_V(6); PG8_BAR; PG8_MMA(1, 1, At, B1); PG8_BAR;
            }
        }
        if constexpr (ALIGN_EPI) { if (wr == 0) PG8_BAR; }
        if constexpr (!Epi::AFTER_DRAIN) { E(acc, cur, wr, wc, fr, fq); S.done(cur); }
        if (!has_next) break;
#pragma unroll
        for (int a = 0; a < 2; ++a)
#pragma unroll
            for (int b = 0; b < 2; ++b)
#pragma unroll
                for (int m = 0; m < 4; ++m)
#pragma unroll
                    for (int n = 0; n < 2; ++n) acc[a][b][m][n] = (f32x4){0.f, 0.f, 0.f, 0.f};
        cur = nxt; cA = nA; cB = nB; ++ui;
        if constexpr (ALIGN_EPI) { if (wr == 1) PG8_BAR; }
    }
    PG8_WAIT_V(0);
    if constexpr (!ALIGN_EPI) { if (wr == 0) PG8_BAR; }
    PG8_BAR;
    if constexpr (Epi::AFTER_DRAIN) { E.fused(acc, cur, wr, wc, fr, fq, lds, wid, lane); S.done(cur); }
#undef PG8_SA
#undef PG8_SB
#undef PG8_STAGE
#undef PG8_LDA
#undef PG8_LDB
#undef PG8_MMA
#undef PG8_WAIT_V
#undef PG8_WAIT_L
#undef PG8_BAR
#undef PG8_SCHED
}
}

namespace fox {
constexpr int D = 128, PITCH = 1024;
constexpr float THR = 8.f;
constexpr bool WSKIP = false;
constexpr float INV_SCALE = 11.313708498984761f;
constexpr float SCALE = 0.08838834764831845f;
constexpr int NW = 8, QBLK = 32, KVBLK = 64, QB = NW * QBLK;
constexpr int SHM_V = KVBLK * D * 2, SHM_K = KVBLK * D * 2;
constexpr int BIAS_OFF = 2 * SHM_V + 2 * SHM_K + NW * 64 * 4;
constexpr int LDS_BYTES = BIAS_OFF + 2 * 64 * 4;

typedef unsigned short bf16;
typedef short bf16x8 __attribute__((ext_vector_type(8)));
typedef short s16x4 __attribute__((ext_vector_type(4)));
typedef float f32x16 __attribute__((ext_vector_type(16)));
typedef float f32x4 __attribute__((ext_vector_type(4)));
typedef unsigned u32x4 __attribute__((ext_vector_type(4)));
template <class A, class Bt> struct same_t { static constexpr bool v = false; };
template <class A> struct same_t<A, A> { static constexpr bool v = true; };

#define KSWZ(row, colB) ((row) * 256 + ((colB) ^ (((row) & 7) << 4)))
#define SBAR() __builtin_amdgcn_sched_barrier(0)
__device__ __forceinline__ int v_st(int k, int c) { const int kk = (k & ~0xC) | ((k & 4) << 1) | ((k & 8) >> 1); return ((kk >> 3) * 4 + (c >> 5)) * 512 + ((kk & 7) * 32 + (c & 31)) * 2; }
__device__ __forceinline__ int v_rd_base(int lane) { return ((lane & 3) << 3) | (((lane >> 2) & 3) << 6) | (((lane >> 4) & 1) << 5) | (((lane >> 5) & 1) << 8); }
constexpr int v_rd_off(int d0, int ks, int half) { return d0 * 512 + ks * 4096 + half * 2048; }
__device__ __forceinline__ int crow(int r, int hi) { return (r & 3) + 8 * (r >> 2) + 4 * hi; }
__device__ __forceinline__ unsigned cvtpk(float lo, float hi) {
    unsigned r; asm volatile("v_cvt_pk_bf16_f32 %0, %1, %2" : "=v"(r) : "v"(lo), "v"(hi)); return r;
}
__device__ __forceinline__ bf16x8 pack8(f32x4 a, f32x4 b) {
    u32x4 w = {cvtpk(a[0], a[1]), cvtpk(a[2], a[3]), cvtpk(b[0], b[1]), cvtpk(b[2], b[3])};
    return *reinterpret_cast<bf16x8*>(&w);
}
template <class T> __device__ __forceinline__ bf16x8 load8(const T* p) {
    if constexpr (same_t<T, float>::v) { return pack8(*(const f32x4*)p, *(const f32x4*)(p + 4)); }
    else { return *reinterpret_cast<const bf16x8*>(p); }
}
__device__ __forceinline__ void mask_tile(f32x16& p0, f32x16& p1, int dq, unsigned W) {
    const float NEG = -__builtin_inff();
#pragma unroll
    for (int r = 0; r < 16; ++r) {
        const int c = (r & 3) + 8 * (r >> 2);
        if ((unsigned)(dq - c) >= W) p0[r] = NEG;
        if ((unsigned)(dq - c - 32) >= W) p1[r] = NEG;
    }
}
__device__ __forceinline__ void partialSM(f32x16& p0, f32x16& p1, float& m_reg, float& mn, float& alpha) {
    float pmax = p0[0]; for (int r = 1; r < 16; ++r) pmax = fmaxf(pmax, p0[r]); for (int r = 0; r < 16; ++r) pmax = fmaxf(pmax, p1[r]);
    { auto rr = __builtin_amdgcn_permlane32_swap(__float_as_uint(pmax), __float_as_uint(pmax), false, false);
      pmax = fmaxf(__uint_as_float(rr[0]), __uint_as_float(rr[1])); }
    constexpr float C2 = 1.4426950408889634f * SCALE;
    if (__builtin_expect(__all((pmax - m_reg) * SCALE <= THR), 1)) { mn = m_reg; alpha = 1.f; }
    else { mn = fmaxf(m_reg, pmax); alpha = __builtin_amdgcn_exp2f((m_reg - mn) * C2); m_reg = mn; }
    const float mnL = -mn * C2;
    for (int r = 0; r < 16; ++r) p0[r] = fmaf(p0[r], C2, mnL); for (int r = 0; r < 16; ++r) p1[r] = fmaf(p1[r], C2, mnL);
    for (int r = 0; r < 16; ++r) p0[r] = __builtin_amdgcn_exp2f(p0[r]);
}
__device__ __forceinline__ void finishSM(f32x16& p0, f32x16& p1, float alpha, float& l_reg, bf16x8& pa0, bf16x8& pa1, bf16x8& pa2, bf16x8& pa3) {
    for (int r = 0; r < 16; ++r) p1[r] = __builtin_amdgcn_exp2f(p1[r]);
    float ps = 0; for (int r = 0; r < 16; ++r) ps += p0[r]; for (int r = 0; r < 16; ++r) ps += p1[r];
    { auto rr = __builtin_amdgcn_permlane32_swap(__float_as_uint(ps), __float_as_uint(ps), false, false);
      ps = __uint_as_float(rr[0]) + __uint_as_float(rr[1]); }
    l_reg = l_reg * alpha + ps;
#define PK4(P, B_, OUT) do { unsigned a0 = cvtpk(P[B_+0], P[B_+1]), a1 = cvtpk(P[B_+2], P[B_+3]);                          \
        unsigned b0 = cvtpk(P[B_+4], P[B_+5]), b1 = cvtpk(P[B_+6], P[B_+7]);                                             \
        auto r0 = __builtin_amdgcn_permlane32_swap(a0, b0, false, false); auto r1 = __builtin_amdgcn_permlane32_swap(a1, b1, false, false); \
        u32x4 w = {r0[0], r1[0], r0[1], r1[1]}; OUT = *reinterpret_cast<bf16x8*>(&w); } while (0)
    PK4(p0, 0, pa0); PK4(p0, 8, pa1); PK4(p1, 0, pa2); PK4(p1, 8, pa3);
#undef PK4
}
template <int KB, bool SK>
__device__ __forceinline__ void qkt(f32x16& p0, f32x16& p1, const char* K_lds, int r32, int hi, const bf16x8* qr, bool act) {
    if (SK && !act) { const float NEG = -__builtin_inff();
#pragma unroll
        for (int r = 0; r < 16; ++r) { p0[r] = NEG; p1[r] = NEG; } return; }
    { const f32x4* bb = (const f32x4*)(K_lds + 2 * SHM_K + NW * 64 * 4 + KB * 256 + hi * 16);
#pragma unroll
      for (int g = 0; g < 4; ++g) { const f32x4 t0 = bb[2 * g], t1 = bb[8 + 2 * g];
#pragma unroll
          for (int i = 0; i < 4; ++i) { p0[4 * g + i] = t0[i]; p1[4 * g + i] = t1[i]; } } }
    const char* kb[4];
#pragma unroll
    for (int dd = 0; dd < 4; ++dd) kb[dd] = K_lds + KB * SHM_K + KSWZ(r32, (dd * 16 + hi * 8) * 2);
#pragma unroll
    for (int d0 = 0; d0 < 8; ++d0) { const char* a = kb[d0 & 3] + (d0 >> 2) * 128;
        bf16x8 b0 = *reinterpret_cast<const bf16x8*>(a);
        bf16x8 b1 = *reinterpret_cast<const bf16x8*>(a + 32 * 256);
        p0 = __builtin_amdgcn_mfma_f32_32x32x16_bf16(b0, qr[d0], p0, 0, 0, 0);
        p1 = __builtin_amdgcn_mfma_f32_32x32x16_bf16(b1, qr[d0], p1, 0, 0, 0); }
}
template <int VB, bool SK>
__device__ __forceinline__ void pv_tile(f32x16* o, int vb0, bf16x8 pa0, bf16x8 pa1, bf16x8 pa2, bf16x8 pa3, bool act) {
    if (SK && !act) return;
#define TRRD(dst, off) asm volatile("ds_read_b64_tr_b16 %0, %1 offset:%2" : "=&v"(dst) : "v"(vb0), "i"(off) : "memory")
#define PV_D0(d0) do { s16x4 l0, l1, l2, l3, h0, h1, h2, h3; constexpr int b_ = VB * SHM_V + v_rd_off(d0, 0, 0);     \
        TRRD(l0, b_); TRRD(h0, b_ + 2048); TRRD(l1, b_ + 4096); TRRD(h1, b_ + 6144); TRRD(l2, b_ + 8192); TRRD(h2, b_ + 10240); TRRD(l3, b_ + 12288); TRRD(h3, b_ + 14336); \
        asm volatile("s_waitcnt lgkmcnt(0)" ::: "memory"); SBAR();                 \
        o[d0] = __builtin_amdgcn_mfma_f32_32x32x16_bf16(pa0, (bf16x8){l0[0], l0[1], l0[2], l0[3], h0[0], h0[1], h0[2], h0[3]}, o[d0], 0, 0, 0);   \
        o[d0] = __builtin_amdgcn_mfma_f32_32x32x16_bf16(pa1, (bf16x8){l1[0], l1[1], l1[2], l1[3], h1[0], h1[1], h1[2], h1[3]}, o[d0], 0, 0, 0);   \
        o[d0] = __builtin_amdgcn_mfma_f32_32x32x16_bf16(pa2, (bf16x8){l2[0], l2[1], l2[2], l2[3], h2[0], h2[1], h2[2], h2[3]}, o[d0], 0, 0, 0);   \
        o[d0] = __builtin_amdgcn_mfma_f32_32x32x16_bf16(pa3, (bf16x8){l3[0], l3[1], l3[2], l3[3], h3[0], h3[1], h3[2], h3[3]}, o[d0], 0, 0, 0); } while (0)
    PV_D0(0); PV_D0(1); PV_D0(2); PV_D0(3);
#undef PV_D0
#undef TRRD
}

template <class TIn, class TOut> struct BlockRef { const TIn* Q; const TIn* K; const TIn* V; TOut* O; const float* cb; float cref; int P0; int jlo; };
template <class TIn> struct Seam {
    bf16x8 qr[8];
    bf16x8 st_v0, st_v1, st_k0, st_k1; float st_c; f32x4 sf0, sf1, sf2, sf3;
    f32x4 tq[16];
};
__device__ __forceinline__ int swa_jlo(int P0, int W) { const int lowk = P0 - W + 1; return lowk > 0 ? lowk / KVBLK : 0; }
#define ROW(p, k0, rr) ((p) + (size_t)((k0) + (rr)) * PITCH + sc)
#define VMW() asm volatile("s_waitcnt vmcnt(0)" ::: "memory")
#define VMWN(n) asm volatile("s_waitcnt vmcnt(%0)" :: "i"(n) : "memory")
#define SLOAD_H(Kp, Vp, Cp, k0) do { S.st_v0 = load8<TIn>(ROW(Vp, k0, sr)); S.st_v1 = load8<TIn>(ROW(Vp, k0, 32 + sr));              \
                         S.st_k0 = load8<TIn>(ROW(Kp, k0, sr)); S.st_k1 = load8<TIn>(ROW(Kp, k0, 32 + sr)); S.st_c = (Cp)[(k0) + lane]; } while (0)
#define SWRITE_HK(bf, cr) do { *(bf16x8*)(K_lds + (bf) * SHM_K + kws) = S.st_k0; *(bf16x8*)(K_lds + (bf) * SHM_K + kws + 32 * 256) = S.st_k1; \
                            if (wid == 0) ((float*)(K_lds + 2 * SHM_K + NW * 64 * 4))[(bf) * 64 + lane] = ((cr) - S.st_c) * INV_SCALE; } while (0)
#define SWRITE_HV(bf) do { *(bf16x8*)(V_lds + (bf) * SHM_V + vst0) = S.st_v0; *(bf16x8*)(V_lds + (bf) * SHM_V + vst1) = S.st_v1; } while (0)
#define SWRITE_H(bf, cr) do { SWRITE_HV(bf); SWRITE_HK(bf, cr); } while (0)
#define SLOAD_F(p, k0) do { S.sf0 = *(const f32x4*)ROW(p, k0, sr); S.sf1 = *(const f32x4*)(ROW(p, k0, sr) + 4);                \
                            S.sf2 = *(const f32x4*)ROW(p, k0, 32 + sr); S.sf3 = *(const f32x4*)(ROW(p, k0, 32 + sr) + 4); } while (0)
#define SWRITE_KF(bf) do { *(bf16x8*)(K_lds + (bf) * SHM_K + kws) = pack8(S.sf0, S.sf1); *(bf16x8*)(K_lds + (bf) * SHM_K + kws + 32 * 256) = pack8(S.sf2, S.sf3); } while (0)
#define SWRITE_VF(bf) do { *(bf16x8*)(V_lds + (bf) * SHM_V + vst0) = pack8(S.sf0, S.sf1); *(bf16x8*)(V_lds + (bf) * SHM_V + vst1) = pack8(S.sf2, S.sf3); } while (0)
template <class TIn, class TOut>
__device__ __forceinline__ void causal_swa_prime(const BlockRef<TIn, TOut>& cur, int W, char* lds, Seam<TIn>& S) {
    constexpr bool F32 = same_t<TIn, float>::v;
    const int tid = pg8::opaque_tid(), wid = __builtin_amdgcn_readfirstlane(tid >> 6), lane = tid & 63, r32 = lane & 31, hi = lane >> 5;
    const int sr = tid >> 4, sc = (tid & 15) * 8, kws = KSWZ(sr, sc * 2); char* K_lds = lds + 2 * SHM_V;
    const int kb0 = cur.jlo * KVBLK;
    for (int d0 = 0; d0 < 8; ++d0) S.qr[d0] = load8<TIn>(cur.Q + (size_t)(wid * QBLK + r32) * PITCH + d0 * 16 + hi * 8);
    if constexpr (F32) { SLOAD_F((const float*)cur.K, kb0); VMW(); SWRITE_KF(0); SBAR(); SLOAD_F((const float*)cur.V, kb0); }
    else { SLOAD_H(cur.K, cur.V, cur.cb, kb0); VMW(); SWRITE_HK(0, cur.cref); }
    __syncthreads();
}
template <class TIn, class TOut>
__device__ __forceinline__ void causal_swa_block(const BlockRef<TIn, TOut>& cur, const BlockRef<TIn, TOut>& nxt, int skv, int W, char* lds, Seam<TIn>& S) {
    constexpr bool F32 = same_t<TIn, float>::v;
    const int tid = pg8::opaque_tid(), wid = __builtin_amdgcn_readfirstlane(tid >> 6), lane = tid & 63, r32 = lane & 31, hi = lane >> 5;
    const int j_lo = cur.jlo;
    int j_hi = (cur.P0 + QB - 1) / KVBLK + 1; if (j_hi > skv / KVBLK) j_hi = skv / KVBLK;
    const int NT = j_hi - j_lo;
    const int kbn = nxt.jlo * KVBLK;
    const int qlo = cur.P0 + wid * QBLK, qm = qlo + r32 - 4 * hi;
    char* V_lds = lds; char* K_lds = lds + 2 * SHM_V;
    float* ws = (float*)(lds + 2 * SHM_V + 2 * SHM_K) + wid * 64; float* li_l = ws, * al_l = ws + 32;
    float m_reg = -1e30f, l_reg = 0; f32x16 o[4] = {};
    const int sr = tid >> 4, sc = (tid & 15) * 8, vst0 = v_st(sr, sc), vst1 = v_st(32 + sr, sc), kws = KSWZ(sr, sc * 2);
    const int vb0 = (int)(uintptr_t)V_lds + v_rd_base(lane);
    const TIn* Kh = cur.K; const TIn* Vh = cur.V;
#define RESC(a) do { if (__any((a) < 1.f)) { if (hi == 0) al_l[r32] = (a); asm volatile("s_waitcnt lgkmcnt(0)" ::: "memory");              \
                     for (int d_ = 0; d_ < 4; ++d_) for (int r = 0; r < 16; ++r) o[d_][r] *= al_l[crow(r, hi)]; } } while (0)
#define KBASE(t) ((j_lo + (t)) * KVBLK)
#define ACT(t) (KBASE(t) <= qlo + QBLK - 1 && KBASE(t) + KVBLK - 1 >= qlo - W + 1)
#define MASKT(P0_, P1_, t) do { const int kb_ = KBASE(t); if ((!SK || ACT(t)) && (kb_ + KVBLK - 1 > qlo || kb_ <= qlo + QBLK - 1 - W)) mask_tile(P0_, P1_, qm - kb_, (unsigned)W); } while (0)
    constexpr int NQL = F32 ? 16 : 8;
    constexpr bool SK = WSKIP && !F32;
#define SEAM_K0() do { VMWN(NQL); if constexpr (F32) { SWRITE_KF(0); SBAR(); SLOAD_F((const float*)nxt.V, kbn); } else { SWRITE_HK(0, nxt.cref); } SBAR(); } while (0)
    f32x16 pA0, pA1, pB0, pB1; float mnA, mnB, alA, alB; bf16x8 pa0, pa1, pa2, pa3;
    if constexpr (F32) { VMW(); SWRITE_VF(0); SBAR(); } else { SWRITE_HV(0); SBAR(); }
    if (NT > 1) { if constexpr (F32) SLOAD_F((const float*)Kh, KBASE(1)); else SLOAD_H(Kh, Vh, cur.cb, KBASE(1)); }
    SBAR(); qkt<0, SK>(pA0, pA1, K_lds, r32, hi, S.qr, ACT(0));
    if constexpr (F32) { if (NT > 1) { VMW(); SWRITE_KF(1); SBAR(); SLOAD_F((const float*)Vh, KBASE(1)); } }
    MASKT(pA0, pA1, 0); partialSM(pA0, pA1, m_reg, mnA, alA);
    if (NT > 1) { VMW(); if constexpr (F32) { SWRITE_VF(1); SBAR(); if (NT > 2) SLOAD_F((const float*)Kh, KBASE(2)); } else SWRITE_H(1, cur.cref); }
    __syncthreads();
#define HALF_STEP(PX0, PX1, mnX, alX, PY0, PY1, alY, t, KB, VB, SB) do {                                                      \
        SBAR(); qkt<KB, SK>(PX0, PX1, K_lds, r32, hi, S.qr, ACT(t));                                             \
        finishSM(PY0, PY1, alY, l_reg, pa0, pa1, pa2, pa3); SBAR();                                                           \
        if ((t) + 1 < NT) { if constexpr (F32) { VMW(); SWRITE_KF(SB); SBAR(); SLOAD_F((const float*)Vh, KBASE((t) + 1)); }  \
                            else { SLOAD_H(Kh, Vh, cur.cb, KBASE((t) + 1)); } SBAR(); }                                               \
        pv_tile<VB, SK>(o, vb0, pa0, pa1, pa2, pa3, ACT((t) - 1)); MASKT(PX0, PX1, (t)); partialSM(PX0, PX1, m_reg, mnX, alX);                                        \
        __syncthreads();                                                                                                      \
        if ((t) + 1 < NT) { VMW(); if constexpr (F32) { SWRITE_VF(SB); SBAR(); if ((t) + 2 < NT) SLOAD_F((const float*)Kh, KBASE((t) + 2)); } \
                            else { SWRITE_H(SB, cur.cref); } }                                                                          \
        RESC(alX); __syncthreads(); } while (0)
    for (int t = 1; t + 1 < NT; t += 2) {
        HALF_STEP(pB0, pB1, mnB, alB, pA0, pA1, alA, t, 1, 0, 0);
        HALF_STEP(pA0, pA1, mnA, alA, pB0, pB1, alB, t + 1, 0, 1, 1);
    }
    const bool even = (NT & 1) == 0;
    if (even) { SBAR(); qkt<1, SK>(pB0, pB1, K_lds, r32, hi, S.qr, ACT(NT - 1)); SBAR(); }
#define QROW(e) (nxt.Q + (size_t)(wid * QBLK + r32) * PITCH + ((e) >> 1) * 16 + hi * 8 + ((e) & 1) * 4)
    if constexpr (F32) { SLOAD_F((const float*)nxt.K, kbn); SBAR();
#pragma unroll
        for (int e = 0; e < 8; ++e) S.tq[e] = *(const f32x4*)QROW(e); }
    else { SLOAD_H(nxt.K, nxt.V, nxt.cb, kbn); SBAR();
#pragma unroll
        for (int d0 = 0; d0 < 8; ++d0) S.qr[d0] = load8<TIn>(nxt.Q + (size_t)(wid * QBLK + r32) * PITCH + d0 * 16 + hi * 8); }
    SBAR();
    finishSM(pA0, pA1, alA, l_reg, pa0, pa1, pa2, pa3); SBAR();
    if constexpr (F32) {
#pragma unroll
        for (int e = 8; e < 16; ++e) S.tq[e] = *(const f32x4*)QROW(e); SBAR(); }
#undef QROW
    pv_tile<0, SK>(o, vb0, pa0, pa1, pa2, pa3, ACT(even ? NT - 2 : NT - 1));
    if (even) { MASKT(pB0, pB1, NT - 1); partialSM(pB0, pB1, m_reg, mnB, alB); __syncthreads(); RESC(alB);
        finishSM(pB0, pB1, alB, l_reg, pa0, pa1, pa2, pa3); SBAR(); pv_tile<1, SK>(o, vb0, pa0, pa1, pa2, pa3, ACT(NT - 1)); }
    SBAR(); SEAM_K0();
    if (hi == 0) li_l[r32] = l_reg; asm volatile("s_waitcnt lgkmcnt(0)" ::: "memory");
    float rli[16];
#pragma unroll
    for (int r = 0; r < 16; ++r) rli[r] = __builtin_amdgcn_rcpf(li_l[crow(r, hi)]);
    TOut* Ow = cur.O + (size_t)(wid * QBLK) * PITCH;
#pragma unroll
    for (int r = 0; r < 16; ++r) { const int orow = crow(r, hi);
#pragma unroll
        for (int d0 = 0; d0 < 4; ++d0) { const float v = o[d0][r] * rli[r];
            if constexpr (same_t<TOut, float>::v) { Ow[(size_t)orow * PITCH + d0 * 32 + r32] = v; }
            else { const float vn = __shfl_xor(v, 1);
                   if ((r32 & 1) == 0) *(unsigned*)(Ow + (size_t)orow * PITCH + d0 * 32 + r32) = cvtpk(v, vn); } } }
    if constexpr (F32) {
#pragma unroll
        for (int d0 = 0; d0 < 8; ++d0) S.qr[d0] = pack8(S.tq[2 * d0], S.tq[2 * d0 + 1]); }
    __syncthreads();
#undef RESC
#undef KBASE
#undef ACT
#undef MASKT
#undef SEAM_K0
#undef HALF_STEP
}
#undef ROW
#undef VMW
#undef VMWN
#undef SLOAD_H
#undef SWRITE_HK
#undef SWRITE_HV
#undef SWRITE_H
#undef SLOAD_F
#undef SWRITE_KF
#undef SWRITE_VF

}

#define GAS __attribute__((address_space(1)))
#define LAS __attribute__((address_space(3)))
typedef unsigned short bf16;
typedef unsigned v4u __attribute__((ext_vector_type(4)));
typedef float f32x4 __attribute__((ext_vector_type(4)));
typedef short bf16x8 __attribute__((ext_vector_type(8)));
typedef GAS unsigned gu32;
typedef GAS unsigned long long gu64;
#define RLX_AGENT __ATOMIC_RELAXED, __HIP_MEMORY_SCOPE_AGENT
#define LDS_WAIT() asm volatile("s_waitcnt lgkmcnt(0)" ::: "memory")
#define VM_WAIT() asm volatile("s_waitcnt vmcnt(0)" ::: "memory")
__device__ __forceinline__ unsigned long long rt() { return __builtin_amdgcn_s_memrealtime(); }
__device__ __forceinline__ unsigned f2bf(float f) { unsigned u = __builtin_bit_cast(unsigned, f); return (u + 0x7fffu + ((u >> 16) & 1u)) >> 16; }
__device__ __forceinline__ unsigned pk2(float lo, float hi) { return f2bf(lo) | (f2bf(hi) << 16); }

#define XB_TMO      128
#define XB_XCNT(j)  (256  + 64 * (j))
#define XB_XSUB(j)  (1280 + 64 * (j))
#define XB_XGEN(j)  (2304 + 64 * (j))
#define XB_TOP      3328
#define XB_TOPGEN   3392
#define XCD_BAR_WORDS 3456
#define XB_SPIN_CAP (1u << 21)

__device__ __forceinline__ unsigned xb_ld(unsigned* p)              { return __hip_atomic_load(p, __ATOMIC_RELAXED, __HIP_MEMORY_SCOPE_AGENT); }
__device__ __forceinline__ unsigned xb_add(unsigned* p, unsigned v) { return __hip_atomic_fetch_add(p, v, __ATOMIC_RELAXED, __HIP_MEMORY_SCOPE_AGENT); }
__device__ __forceinline__ unsigned xb_xcc_id() { return (unsigned)__builtin_amdgcn_s_getreg((3 << 11) | 20) & 0xFu; }
#define XB_SPIN(cond, bar) do { unsigned _sp = 0; while (cond) { __builtin_amdgcn_s_sleep(1); \
    if ((++_sp & 255u) == 0u) { if (xb_ld(&(bar)[XB_TMO])) break; if (_sp > XB_SPIN_CAP) { atomicAdd(&(bar)[XB_TMO], 1u); break; } } } } while (0)

struct XcdBarrier {
    unsigned* bar; unsigned x;
    volatile LAS unsigned* st;
};

__device__ __forceinline__ XcdBarrier xcd_barrier_post(unsigned* bar, volatile LAS unsigned* st) {
    XcdBarrier b; b.bar = bar; b.x = xb_xcc_id(); b.st = st;
    if (threadIdx.x == 0) (void)xb_add(&bar[XB_XCNT(b.x)], 1u);
    return b;
}
__device__ __forceinline__ void xcd_barrier_complete(unsigned* bar, unsigned x, unsigned& nloc, unsigned& nx) {
    const unsigned G = gridDim.x * gridDim.y * gridDim.z;
    unsigned sum, cnt, mine, sp = 0u;
    for (;;) {
        sum = 0u; cnt = 0u; mine = 0u;
#pragma unroll
        for (unsigned j = 0; j < 16; ++j) { const unsigned c = xb_ld(&bar[XB_XCNT(j)]); sum += c; cnt += (c > 0u) ? 1u : 0u; mine = (j == x) ? c : mine; }
        if (sum == G) break;
        __builtin_amdgcn_s_sleep(1);
        if ((++sp & 255u) == 0u) { if (xb_ld(&bar[XB_TMO])) break; if (sp > XB_SPIN_CAP) { atomicAdd(&bar[XB_TMO], 1u); break; } }
    }
    nloc = mine > 0u ? mine : 1u; nx = cnt > 0u ? cnt : 1u;
}

__device__ __forceinline__ void xcd_barrier(const XcdBarrier& b) {
    asm volatile("s_waitcnt vmcnt(0)" ::: "memory");
    __syncthreads();
    if (threadIdx.x == 0) {
        unsigned* bar = b.bar;
        __builtin_amdgcn_s_waitcnt(0);
        unsigned nloc = b.st[0], nx = b.st[1];
        if (nloc == 0u) { xcd_barrier_complete(bar, b.x, nloc, nx); b.st[0] = nloc; b.st[1] = nx; }
        const unsigned old = xb_add(&bar[XB_XSUB(b.x)], 1u);
        const unsigned gen = old / nloc;
        if (old + 1u == (gen + 1u) * nloc) {
            __builtin_amdgcn_fence(__ATOMIC_RELEASE, "agent");
            asm volatile("s_waitcnt vmcnt(0)" ::: "memory");
            const unsigned og = xb_add(&bar[XB_TOP], 1u);
            const unsigned tg = og / nx;
            if (og + 1u == (tg + 1u) * nx) xb_add(&bar[XB_TOPGEN], 1u);
            else XB_SPIN(xb_ld(&bar[XB_TOPGEN]) == tg, bar);
            __builtin_amdgcn_fence(__ATOMIC_ACQUIRE, "agent");
            xb_add(&bar[XB_XGEN(b.x)], 1u);
            asm volatile("s_waitcnt vmcnt(0)" ::: "memory");
        } else {
            XB_SPIN(xb_ld(&bar[XB_XGEN(b.x)]) == gen, bar);
            __builtin_amdgcn_fence(__ATOMIC_ACQUIRE, "agent");
            asm volatile("s_waitcnt vmcnt(0)" ::: "memory");
        }
    }
    __syncthreads();
}

constexpr int NWAVES = 8;
#ifndef MK_PER_PHASE
#define MK_PER_PHASE 0
#endif
constexpr int BATCH = 2, SEQ = 16384, DM = 2048, MTOK = BATCH * SEQ;
constexpr int DCONV = 1024, NH = 8, DATT = 1024, PTOT = 10248, NPROJ = 10240;
constexpr int DFF = 5632, NE = 8, DFFE = 7168;
constexpr int RMAX = MTOK + NE * 256;
constexpr float RMS_EPS = 1e-6f;
constexpr size_t MiB = 1u << 20;
constexpr size_t WS_CTL = 0, CTL_ZERO_BYTES = 1 * MiB;
constexpr size_t WS_LOGF = 1 * MiB;
constexpr size_t WS_CB = 2 * MiB;
constexpr size_t WS_TOKE = 3 * MiB;
constexpr size_t WS_TOKW = 3 * MiB + 512 * 1024;
constexpr size_t WS_ROWTOK = 4 * MiB;
constexpr size_t WS_ROWW = 5 * MiB;
constexpr size_t WS_WIN = 8 * MiB;
constexpr size_t WS_WCO = WS_WIN + 80 * MiB;
constexpr size_t WS_WAO = WS_WCO + 8 * MiB;
constexpr size_t WS_WO = WS_WAO + 8 * MiB;
constexpr size_t WS_WGU = WS_WO + 16 * MiB;
constexpr size_t WS_WDD = WS_WGU + 44 * MiB;
constexpr size_t WS_MWGU = WS_WDD + 22 * MiB;
constexpr size_t WS_MWD = WS_MWGU + 448 * MiB;
constexpr size_t WS_A = WS_MWD + 224 * MiB;
constexpr size_t WS_P6 = WS_A + 128 * MiB;
constexpr size_t WS_G = WS_P6 + 384 * MiB;
constexpr size_t WS_END = WS_G + 256 * MiB;
constexpr size_t WS_HID = WS_P6;
constexpr size_t WS_XG = WS_P6 + 476 * MiB;
static_assert((size_t)RMAX * DFFE * 2 <= 476 * MiB && WS_XG + (size_t)RMAX * DM * 2 <= WS_END && (size_t)MTOK * DFF * 2 <= 476 * MiB, "overlay");
static_assert((size_t)2 * NPROJ * DM * 2 == 80 * MiB && (size_t)2 * DFF * DM * 2 == 44 * MiB && (size_t)NE * 2 * DFFE * DM * 2 == 448 * MiB, "weights");
constexpr int CW_CNT = 64;
constexpr int CW_CUR = 128;
constexpr int CW_NMAX = 192;
constexpr int CW_BAR = 4096;
constexpr int RING_BYTES = 131072;
constexpr int LDSCTL_OFF = RING_BYTES, MISC_OFF = LDSCTL_OFF + 320, TILE_E_OFF = LDSCTL_OFF + 1024, JLO_OFF = LDSCTL_OFF + 2048;
constexpr float PRUNE_T = 32.f;
constexpr int LDS_BYTES = 147456;
enum { I_X = 0, I_MIXN, I_WIN, I_BF, I_CONVW, I_WCO, I_WAO, I_WO, I_FFNN, I_DWG, I_DWU, I_DWD, I_RW, I_RB, I_MWG, I_MWU, I_MWD, I_FN, N_IN };

struct Args { const float* in[N_IN]; float* out; unsigned char* ws; int ph_lo, ph_hi; };
struct Frame { LAS unsigned char* lds; int tid, lane, wave, vcu, G; };
#define KAS __attribute__((address_space(4)))
typedef const KAS Args* ArgsP;

__device__ __forceinline__ float wave_sum(float v, int lane) {
#pragma unroll
    for (int o = 1; o < 64; o <<= 1) v += __int_as_float(__builtin_amdgcn_ds_bpermute((lane ^ o) << 2, __float_as_int(v)));
    return v;
}
struct CvtJob { const float* src; bf16* dst; int ldw, col_off, ncols, K, kind, row_off; };
__device__ __forceinline__ void get_job(ArgsP a, int j, CvtJob& J) {
    if (j < 4) { const int l = j >> 1, p = j & 1; J.src = a->in[I_WIN] + (size_t)l * DM * PTOT; J.ldw = PTOT; J.col_off = p ? 6152 : 0; J.ncols = p ? 4096 : 6144; J.K = DM;
        J.dst = (bf16*)(a->ws + WS_WIN) + (size_t)l * NPROJ * DM; J.kind = 0; J.row_off = p ? 6144 : 0; }
    else if (j < 8) { const int l = j & 1, w = (j - 4) >> 1; J.src = a->in[w ? I_WAO : I_WCO] + (size_t)l * 1024 * DM; J.ldw = DM; J.col_off = 0; J.ncols = DM; J.K = 1024;
        J.dst = (bf16*)(a->ws + (w ? WS_WAO : WS_WCO)) + (size_t)l * DM * 1024; J.kind = 0; J.row_off = 0; }
    else if (j < 10) { const int l = j & 1; J.src = a->in[I_WO] + (size_t)l * DM * DM; J.ldw = DM; J.col_off = 0; J.ncols = DM; J.K = DM; J.dst = (bf16*)(a->ws + WS_WO) + (size_t)l * DM * DM; J.kind = 0; J.row_off = 0; }
    else if (j < 12) { const int u = j - 10; J.src = a->in[u ? I_DWU : I_DWG]; J.ldw = DFF; J.col_off = 0; J.ncols = DFF; J.K = DM; J.dst = (bf16*)(a->ws + WS_WGU); J.kind = 1; J.row_off = u ? 128 : 0; }
    else if (j < 13) { J.src = a->in[I_DWD]; J.ldw = DM; J.col_off = 0; J.ncols = DM; J.K = DFF; J.dst = (bf16*)(a->ws + WS_WDD); J.kind = 0; J.row_off = 0; }
    else if (j < 29) { const int e = (j - 13) & 7, u = (j - 13) >> 3; J.src = a->in[u ? I_MWU : I_MWG] + (size_t)e * DM * DFFE; J.ldw = DFFE; J.col_off = 0; J.ncols = DFFE; J.K = DM;
        J.dst = (bf16*)(a->ws + WS_MWGU) + (size_t)e * 2 * DFFE * DM; J.kind = 1; J.row_off = u ? 128 : 0; }
    else { const int e = j - 29; J.src = a->in[I_MWD] + (size_t)e * DFFE * DM; J.ldw = DM; J.col_off = 0; J.ncols = DM; J.K = DFFE; J.dst = (bf16*)(a->ws + WS_MWD) + (size_t)e * DM * DFFE; J.kind = 0; J.row_off = 0; }
}
constexpr int N_CVT_JOBS = 37;
__device__ __forceinline__ void cvt_item(const CvtJob& J, int item, int lane) {
    const int nblk = J.ncols >> 5, kb = item / nblk, nb = item - kb * nblk;
    const int kq = lane >> 3, n4 = lane & 7;
    const float* s = J.src + (size_t)(kb * 64 + kq * 8) * J.ldw + J.col_off + nb * 32 + n4 * 4;
    f32x4 v[8];
#pragma unroll
    for (int e = 0; e < 8; ++e) v[e] = *(const GAS f32x4*)(s + (size_t)e * J.ldw);
    const int src_lane = ((lane & 7) << 3) | (lane >> 3);
    unsigned w[4][4];
#pragma unroll
    for (int j = 0; j < 4; ++j)
#pragma unroll
        for (int q = 0; q < 4; ++q) w[j][q] = (unsigned)__builtin_amdgcn_ds_bpermute(src_lane << 2, (int)pk2(v[2 * q][j], v[2 * q + 1][j]));
    const int n0 = nb * 32 + (lane >> 3) * 4, k0 = kb * 64 + (lane & 7) * 8;
    const int drow = (J.kind == 1 ? 256 * (n0 >> 7) + (n0 & 127) : n0) + J.row_off;
#pragma unroll
    for (int j = 0; j < 4; ++j) { v4u o; o.x = w[j][0]; o.y = w[j][1]; o.z = w[j][2]; o.w = w[j][3]; *(GAS v4u*)(J.dst + (size_t)(drow + j) * J.K + k0) = o; }
}
__device__ __forceinline__ void phase_convert(const Frame& F, ArgsP a) {
    const int gw = F.vcu * NWAVES + F.wave, NGW = F.G * NWAVES; int off = 0;
    for (int j = 0; j < N_CVT_JOBS; ++j) { CvtJob J; get_job(a, j, J); const int nit = (J.K >> 6) * (J.ncols >> 5);
        int i0 = (gw - off) % NGW; if (i0 < 0) i0 += NGW;
        for (int it = i0; it < nit; it += NGW) cvt_item(J, it, F.lane);
        off = (off + nit) % NGW; }
}
__device__ __forceinline__ float log_sigmoid(float x) {
    const float y = __builtin_amdgcn_exp2f(-1.4426950408889634f * __builtin_fabsf(x));
    const float l1p = y < 1e-3f ? y * (1.0f - 0.5f * y) : 0.6931471805599453f * __builtin_amdgcn_logf(1.0f + y);
    return fminf(x, 0.f) - l1p;
}
__device__ __forceinline__ void stage_w8(const Frame& F, const float* w8, int ldw) {
    LAS float* wl = (LAS float*)F.lds;
    for (int col = F.tid; col < DM; col += NWAVES * 64) { const int j = col >> 8, ln = (col & 255) >> 2, e = col & 3;
        const f32x4 a = *(const GAS f32x4*)(w8 + (size_t)col * ldw), b = *(const GAS f32x4*)(w8 + (size_t)col * ldw + 4);
        LAS f32x4* d = (LAS f32x4*)(wl + ((j * 4 + e) * 64 + ln) * 8); d[0] = a; d[1] = b; }
    __syncthreads();
}
template <int MODE>
__device__ __forceinline__ void phase_norm(const Frame& F, ArgsP a, const float* hin, const float* gain, bf16* aout, float* fout, const float* w8, int ldw8, const float* b8) {
    if (MODE == 0 || MODE == 2) stage_w8(F, w8, ldw8);
    const LAS float* wl = (const LAS float*)F.lds;
    f32x4 g[8];
#pragma unroll
    for (int j = 0; j < 8; ++j) g[j] = *(const GAS f32x4*)(gain + 256 * j + 4 * F.lane);
    float bb[8];
#pragma unroll
    for (int h = 0; h < 8; ++h) bb[h] = (MODE == 0 || MODE == 2) ? b8[h] : 0.f;
    const int RPW = MTOK / (F.G * NWAVES);
    const int gw = F.vcu * NWAVES + F.wave; const int r0 = gw * RPW;
    float* logf = (float*)(a->ws + WS_LOGF); int* tokE = (int*)(a->ws + WS_TOKE); float* tokW = (float*)(a->ws + WS_TOKW);
    int mycnt = 0;
    for (int r = r0; r < r0 + RPW; ++r) {
        const GAS f32x4* xr = (const GAS f32x4*)(hin + (size_t)r * DM) + F.lane;
        f32x4 v[8]; float ss = 0.f;
#pragma unroll
        for (int j = 0; j < 8; ++j) { v[j] = xr[64 * j]; ss += (v[j].x * v[j].x + v[j].y * v[j].y) + (v[j].z * v[j].z + v[j].w * v[j].w); }
        const float rstd = 1.0f / sqrtf(wave_sum(ss, F.lane) * (1.0f / DM) + RMS_EPS);
#pragma unroll
        for (int j = 0; j < 8; ++j) v[j] = v[j] * rstd * g[j];
        if (MODE == 3) { GAS f32x4* o = (GAS f32x4*)(fout + (size_t)r * DM) + F.lane;
#pragma unroll
            for (int j = 0; j < 8; ++j) o[64 * j] = v[j]; }
        else { GAS unsigned long long* o8 = (GAS unsigned long long*)(aout + (size_t)r * DM) + F.lane;
#pragma unroll
            for (int j = 0; j < 8; ++j) o8[64 * j] = (unsigned long long)pk2(v[j].x, v[j].y) | ((unsigned long long)pk2(v[j].z, v[j].w) << 32); }
        if (MODE == 0 || MODE == 2) {
            float acc[8];
#pragma unroll
            for (int h = 0; h < 8; ++h) acc[h] = 0.f;
#pragma unroll
            for (int j = 0; j < 8; ++j) { asm volatile("" ::: "memory");
#pragma unroll
                for (int e = 0; e < 4; ++e) { const LAS f32x4* wp = (const LAS f32x4*)(wl + ((j * 4 + e) * 64 + F.lane) * 8); const f32x4 w0 = wp[0], w1 = wp[1]; const float x = v[j][e];
                    acc[0] += x * w0.x; acc[1] += x * w0.y; acc[2] += x * w0.z; acc[3] += x * w0.w; acc[4] += x * w1.x; acc[5] += x * w1.y; acc[6] += x * w1.z; acc[7] += x * w1.w; } }
#pragma unroll
            for (int h = 0; h < 8; ++h) acc[h] = wave_sum(acc[h], F.lane) + bb[h];
            if (MODE == 0) {
                float mine = acc[0];
#pragma unroll
                for (int h = 1; h < 8; ++h) mine = (F.lane == h) ? acc[h] : mine;
                if (F.lane < 8) logf[(size_t)r * 8 + F.lane] = log_sigmoid(mine);
            } else {
                int i1 = 0; float l1 = acc[0];
#pragma unroll
                for (int h = 1; h < 8; ++h) if (acc[h] > l1) { l1 = acc[h]; i1 = h; }
                int i2 = -1; float l2 = -3.0e38f;
#pragma unroll
                for (int h = 0; h < 8; ++h) if (h != i1 && acc[h] > l2) { l2 = acc[h]; i2 = h; }
                const float w1 = 1.0f / (1.0f + __builtin_amdgcn_exp2f(1.4426950408889634f * (l2 - l1))), w2 = 1.0f - w1;
                if (F.lane == 0) { tokE[2 * r] = i1; tokE[2 * r + 1] = i2; tokW[2 * r] = w1; tokW[2 * r + 1] = w2; }
                if (F.lane < 16) mycnt += ((F.lane < 8 ? i1 : i2) == (F.lane & 7)) ? 1 : 0;
            }
        }
    }
    if (MODE == 2) {
        if (F.lane < 16 && mycnt) __hip_atomic_fetch_add((unsigned*)a->ws + CW_CNT + F.lane, (unsigned)mycnt, __ATOMIC_RELAXED, __HIP_MEMORY_SCOPE_AGENT);
        int* rt = (int*)(a->ws + WS_ROWTOK);
        for (int i = (F.vcu * NWAVES * 64) + F.tid; i < 2 * RMAX; i += F.G * NWAVES * 64) rt[i] = -1;
    }
}
__device__ __forceinline__ void phase_conv(const Frame& F, ArgsP a, const float* convw  , int layer) {
    if (F.vcu < BATCH * NH) {
        const int b = F.vcu >> 3, h = F.vcu & 7; const float* lf = (const float*)(a->ws + WS_LOGF) + ((size_t)b * SEQ) * 8 + h; float* cb = (float*)(a->ws + WS_CB) + (size_t)F.vcu * SEQ;
        LAS float* wt = (LAS float*)F.lds;
        float v[32]; float run = 0.f;
#pragma unroll
        for (int i = 0; i < 32; ++i) { run += lf[(size_t)(F.tid * 32 + i) * 8]; v[i] = run; }
        float inc = run;
#pragma unroll
        for (int o = 1; o < 64; o <<= 1) { const float t = __int_as_float(__builtin_amdgcn_ds_bpermute(((F.lane - o) & 63) << 2, __float_as_int(inc))); if (F.lane >= o) inc += t; }
        if (F.lane == 63) wt[F.wave] = inc;
        __syncthreads();
        float base = inc - run;
        for (int w = 0; w < F.wave; ++w) base += wt[w];
#pragma unroll
        for (int i = 0; i < 32; ++i) cb[F.tid * 32 + i] = base + v[i];
        __syncthreads();
    }
    bf16* Bz = (bf16*)(a->ws + WS_P6); const bf16* Cb = Bz + (size_t)MTOK * 1024; const bf16* Ub = Bz + (size_t)2 * MTOK * 1024;
    const int gw = F.vcu * NWAVES + F.wave, NGW = F.G * NWAVES;
    { const bf16* Qb = Bz + (size_t)3 * MTOK * 1024; const bf16* Kb = Bz + (size_t)4 * MTOK * 1024; const int RPW = MTOK / NGW, r0 = gw * RPW; float qm = 0.f, km = 0.f;
      for (int r = r0; r < r0 + RPW; ++r) {
          const GAS v4u* qp = (const GAS v4u*)(Qb + (size_t)r * 1024) + 2 * F.lane; const GAS v4u* kp = (const GAS v4u*)(Kb + (size_t)r * 1024) + 2 * F.lane;
          const v4u q0 = qp[0], q1 = qp[1], k0 = kp[0], k1 = kp[1];
          const unsigned qq[8] = {q0.x, q0.y, q0.z, q0.w, q1.x, q1.y, q1.z, q1.w}, kk[8] = {k0.x, k0.y, k0.z, k0.w, k1.x, k1.y, k1.z, k1.w}; float sq = 0.f, sk = 0.f;
#pragma unroll
          for (int i = 0; i < 8; ++i) { const float a0 = pg8::bf_lo(qq[i]), a1 = pg8::bf_hi(qq[i]), b0 = pg8::bf_lo(kk[i]), b1 = pg8::bf_hi(kk[i]); sq += a0 * a0 + a1 * a1; sk += b0 * b0 + b1 * b1; }
#pragma unroll
          for (int o = 1; o < 8; o <<= 1) { sq += __int_as_float(__builtin_amdgcn_ds_bpermute((F.lane ^ o) << 2, __float_as_int(sq))); sk += __int_as_float(__builtin_amdgcn_ds_bpermute((F.lane ^ o) << 2, __float_as_int(sk))); }
          qm = fmaxf(qm, sq); km = fmaxf(km, sk); }
      if ((F.lane & 7) == 0) { unsigned* nm = (unsigned*)a->ws + CW_NMAX + layer * 32 + (r0 / SEQ) * 8 + (F.lane >> 3);
          __hip_atomic_fetch_max(nm, __float_as_uint(qm), __ATOMIC_RELAXED, __HIP_MEMORY_SCOPE_AGENT); __hip_atomic_fetch_max(nm + 16, __float_as_uint(km), __ATOMIC_RELAXED, __HIP_MEMORY_SCOPE_AGENT); } }
    for (int it = gw; it < (MTOK / 32) * 2; it += NGW) {
        const int hf = it & 1, t0 = (it >> 1) * 32, c0 = hf * 512 + F.lane * 8;
        float w0[8], w1[8], w2[8];
#pragma unroll
        for (int i = 0; i < 8; ++i) { w0[i] = convw[c0 + i]; w1[i] = convw[1024 + c0 + i]; w2[i] = convw[2048 + c0 + i]; }
        float p2[8], p1[8];
        const bool first = (t0 % SEQ) == 0;
        { v4u cw = {0u, 0u, 0u, 0u}, uw = cw, cw1 = cw, uw1 = cw;
          if (!first) { cw = *(const GAS v4u*)(Cb + (size_t)(t0 - 2) * 1024 + c0); uw = *(const GAS v4u*)(Ub + (size_t)(t0 - 2) * 1024 + c0);
                        cw1 = *(const GAS v4u*)(Cb + (size_t)(t0 - 1) * 1024 + c0); uw1 = *(const GAS v4u*)(Ub + (size_t)(t0 - 1) * 1024 + c0); }
          const unsigned cc[4] = {cw.x, cw.y, cw.z, cw.w}, uu[4] = {uw.x, uw.y, uw.z, uw.w}, cc1[4] = {cw1.x, cw1.y, cw1.z, cw1.w}, uu1[4] = {uw1.x, uw1.y, uw1.z, uw1.w};
#pragma unroll
          for (int q = 0; q < 4; ++q) { p2[2 * q] = pg8::bf_lo(cc[q]) * pg8::bf_lo(uu[q]); p2[2 * q + 1] = pg8::bf_hi(cc[q]) * pg8::bf_hi(uu[q]);
                                        p1[2 * q] = pg8::bf_lo(cc1[q]) * pg8::bf_lo(uu1[q]); p1[2 * q + 1] = pg8::bf_hi(cc1[q]) * pg8::bf_hi(uu1[q]); } }
#pragma unroll 4
        for (int i = 0; i < 32; ++i) { const size_t o = (size_t)(t0 + i) * 1024 + c0;
            const v4u cw = *(const GAS v4u*)(Cb + o), uw = *(const GAS v4u*)(Ub + o), bw = *(const GAS v4u*)(Bz + o);
            const unsigned cc[4] = {cw.x, cw.y, cw.z, cw.w}, uu[4] = {uw.x, uw.y, uw.z, uw.w}, bq[4] = {bw.x, bw.y, bw.z, bw.w}; float cur[8], z[8];
#pragma unroll
            for (int q = 0; q < 4; ++q) { cur[2 * q] = pg8::bf_lo(cc[q]) * pg8::bf_lo(uu[q]); cur[2 * q + 1] = pg8::bf_hi(cc[q]) * pg8::bf_hi(uu[q]); }
#pragma unroll
            for (int q = 0; q < 4; ++q) { z[2 * q] = pg8::bf_lo(bq[q]) * (w0[2 * q] * p2[2 * q] + w1[2 * q] * p1[2 * q] + w2[2 * q] * cur[2 * q]);
                                          z[2 * q + 1] = pg8::bf_hi(bq[q]) * (w0[2 * q + 1] * p2[2 * q + 1] + w1[2 * q + 1] * p1[2 * q + 1] + w2[2 * q + 1] * cur[2 * q + 1]); }
            v4u ow; ow.x = pk2(z[0], z[1]); ow.y = pk2(z[2], z[3]); ow.z = pk2(z[4], z[5]); ow.w = pk2(z[6], z[7]);
            *(GAS v4u*)(Bz + o) = ow;
#pragma unroll
            for (int q = 0; q < 8; ++q) { p2[q] = p1[q]; p1[q] = cur[q]; } }
    }
}
__device__ __forceinline__ fox::BlockRef<fox::bf16, fox::bf16> fox_ref(ArgsP a, int bh, int qb, int jlo) {
    fox::bf16* P6 = (fox::bf16*)(a->ws + WS_P6); const int b = bh >> 3, h = bh & 7; const size_t base = (size_t)b * SEQ * 1024 + h * 128;
    fox::BlockRef<fox::bf16, fox::bf16> r;
    r.Q = P6 + (size_t)3 * MTOK * 1024 + base + (size_t)qb * 256 * 1024; r.O = (fox::bf16*)r.Q;
    r.K = P6 + (size_t)4 * MTOK * 1024 + base; r.V = P6 + (size_t)5 * MTOK * 1024 + base;
    r.cb = (const float*)(a->ws + WS_CB) + (size_t)bh * SEQ; r.P0 = qb * 256; r.cref = r.cb[r.P0]; r.jlo = jlo;
    return r;
}
__device__ __forceinline__ void phase_attn(const Frame& F, ArgsP a, char* lds, int layer) {
    constexpr int NQB = SEQ / 256, NX = NQB / 2, TOTAL = BATCH * NH * NX;
    LAS int* jl = (LAS int*)(F.lds + JLO_OFF);
    for (int k = 0; k < 4; ++k) {
        const int Lk = F.vcu + (k >> 1) * F.G; int jlo = 0;
        if (Lk < TOTAL) { const int bh = Lk / NX, x = Lk % NX, qb = (k & 1) ? NQB - 1 - x : x, P0 = qb * 256, nt0 = P0 / 64;
            const float* cb = (const float*)(a->ws + WS_CB) + (size_t)bh * SEQ; const unsigned* nm = (const unsigned*)a->ws + CW_NMAX + layer * 32;
            const float U = fox::SCALE * sqrtf(__uint_as_float(nm[bh]) * __uint_as_float(nm[16 + bh])) * 1.001f, thr = 2.f * U + PRUNE_T, cref = cb[P0];
            bool keep = false; if (F.tid < nt0) keep = (cref - cb[64 * F.tid + 63]) > -thr;
            const unsigned long long m = __ballot(keep); const int first = m ? F.wave * 64 + (int)__builtin_ctzll(m) : (1 << 20);
            if (F.lane == 0) jl[4 + F.wave] = first;
            __syncthreads();
            jlo = nt0;
#pragma unroll
            for (int w = 0; w < 8; ++w) jlo = min(jlo, jl[4 + w]);
            __syncthreads(); }
        if (F.tid == 0) jl[k] = jlo;
    }
    __syncthreads();
    int L = F.vcu; if (L >= TOTAL) return;
    int pass = 0, it = 0;
    fox::BlockRef<fox::bf16, fox::bf16> cur = fox_ref(a, L / NX, L % NX, jl[0]);
    fox::Seam<fox::bf16> S;
    fox::causal_swa_prime<fox::bf16, fox::bf16>(cur, SEQ, lds, S);
    for (;;) {
        const bool more_pass = pass == 0, more_item = L + F.G < TOTAL, last = !more_pass && !more_item;
        int passn = pass + 1, Ln = L, itn = it;
        if (!more_pass) { passn = 0; Ln = more_item ? L + F.G : L; itn = more_item ? it + 1 : it; }
        const int xn = Ln % NX;
        const fox::BlockRef<fox::bf16, fox::bf16> nxt = last ? cur : fox_ref(a, Ln / NX, passn ? NQB - 1 - xn : xn, jl[(2 * itn + passn) & 3]);
        fox::causal_swa_block<fox::bf16, fox::bf16>(cur, nxt, SEQ, SEQ, lds, S);
        if (last) break;
        cur = nxt; pass = passn; L = Ln; it = itn;
    }
}
struct MoeLayout { int base[8]; int ntiles; };
__device__ __forceinline__ void moe_layout(ArgsP a, int rank, MoeLayout& ml) {
    const unsigned* cnt = (const unsigned*)a->ws + CW_CNT + rank * 8; int run = 0;
#pragma unroll
    for (int e = 0; e < 8; ++e) { ml.base[e] = run; run += ((int)cnt[e] + 255) & ~255; }
    ml.ntiles = run >> 8;
}
__device__ __forceinline__ void moe_tile_table(const Frame& F, ArgsP a, int rank, int& ntiles) {
    MoeLayout ml; moe_layout(a, rank, ml); ntiles = ml.ntiles;
    LAS int* te = (LAS int*)(F.lds + TILE_E_OFF);
    for (int t = F.tid; t < 160; t += NWAVES * 64) { int e = 0;
#pragma unroll
        for (int q = 1; q < 8; ++q) e += (t * 256 >= ml.base[q]) ? 1 : 0;
        te[t] = e; }
    __syncthreads();
}
__device__ __forceinline__ void gather_row(const bf16* src, bf16* dst, int lane) {
    const GAS v4u* s = (const GAS v4u*)src + lane; GAS v4u* d = (GAS v4u*)dst + lane;
    const v4u a0 = s[0], a1 = s[64], a2 = s[128], a3 = s[192]; d[0] = a0; d[64] = a1; d[128] = a2; d[192] = a3;
}
__device__ __forceinline__ void phase_route(const Frame& F, ArgsP a) {
    MoeLayout ml0, ml1; moe_layout(a, 0, ml0); moe_layout(a, 1, ml1);
    const int* tokE = (const int*)(a->ws + WS_TOKE); const float* tokW = (const float*)(a->ws + WS_TOKW);
    int* rowtok = (int*)(a->ws + WS_ROWTOK); float* roww = (float*)(a->ws + WS_ROWW); unsigned* cur = (unsigned*)a->ws + CW_CUR;
    const bf16* A2 = (const bf16*)(a->ws + WS_A); bf16* XG = (bf16*)(a->ws + WS_XG);
    const int gw = F.vcu * NWAVES + F.wave, NGW = F.G * NWAVES;
    for (int t0 = gw * 16; t0 < MTOK; t0 += NGW * 16) {
        const bool act = F.lane < 16; const int t = t0 + (F.lane & 15);
        int pos0 = 0;
#pragma unroll
        for (int rank = 0; rank < 2; ++rank) {
            const int e = act ? tokE[2 * t + rank] : -1; const float w = act ? tokW[2 * t + rank] : 0.f; int pos = -1;
#pragma unroll
            for (int q = 0; q < 8; ++q) { const unsigned long long m = __ballot(e == q);
                if (m) { unsigned b0 = 0; if (F.lane == 0) b0 = __hip_atomic_fetch_add(cur + rank * 8 + q, (unsigned)__popcll(m), __ATOMIC_RELAXED, __HIP_MEMORY_SCOPE_AGENT);
                    b0 = __builtin_amdgcn_readfirstlane(b0);
                    if (e == q) pos = (rank ? ml1.base[q] : ml0.base[q]) + (int)b0 + __popcll(m & ((1ull << F.lane) - 1ull)); } }
            if (act) { rowtok[rank * RMAX + pos] = t; roww[rank * RMAX + pos] = w; }
            if (rank == 0) pos0 = pos;
        }
        for (int i = 0; i < 16; ++i) { const int p = __builtin_amdgcn_readlane(pos0, i); gather_row(A2 + (size_t)(t0 + i) * DM, XG + (size_t)p * DM, F.lane); }
    }
}
__device__ __forceinline__ void phase_gather(const Frame& F, ArgsP a, int rank) {
    MoeLayout ml; moe_layout(a, rank, ml);
    const int* rowtok = (const int*)(a->ws + WS_ROWTOK) + rank * RMAX; const bf16* A2 = (const bf16*)(a->ws + WS_A); bf16* XG = (bf16*)(a->ws + WS_XG);
    const int gw = F.vcu * NWAVES + F.wave, NGW = F.G * NWAVES, nrows = ml.ntiles * 256;
    for (int p = gw; p < nrows; p += NGW) { const int t = rowtok[p]; if (t >= 0) gather_row(A2 + (size_t)t * DM, XG + (size_t)p * DM, F.lane); }
}

__global__ void __launch_bounds__(NWAVES * 64, 2) fwd(Args args) {
    extern __shared__ __attribute__((aligned(16))) unsigned char lds_raw[];
    { const int t0 = threadIdx.x; for (int u = t0; u < (LDS_BYTES - LDSCTL_OFF) / 4; u += NWAVES * 64) ((LAS unsigned*)((LAS unsigned char*)lds_raw + LDSCTL_OFF))[u] = 0u; }
    __syncthreads();
    (void)xcd_barrier_post((unsigned*)args.ws + CW_BAR, (volatile LAS unsigned*)((LAS unsigned char*)lds_raw + MISC_OFF) + 8);
    const int lo = args.ph_lo, hi = args.ph_hi; int ph = 0;
#define PH_ON (ph >= lo && ph < hi)
#define PH_SEAM() do { if (ph + 1 < hi) { XcdBarrier b2; b2.bar = (unsigned*)ws + CW_BAR; b2.x = xb_xcc_id(); b2.st = (volatile LAS unsigned*)((LAS unsigned char*)lds_raw + MISC_OFF) + 8; xcd_barrier(b2); } } while (0)
#define PH_FRAME() Frame F; F.lds = (LAS unsigned char*)lds_raw; F.tid = pg8::opaque_tid(); F.lane = F.tid & 63; F.wave = __builtin_amdgcn_readfirstlane(F.tid >> 6); \
    F.G = gridDim.x; { const int bx = blockIdx.x; F.vcu = (F.G % 8 == 0) ? (bx % 8) * (F.G / 8) + bx / 8 : bx; } \
    ArgsP A = (ArgsP)__builtin_amdgcn_kernarg_segment_ptr(); asm volatile("" : "+s"(A)); unsigned char* ws = A->ws; float* const out = A->out; (void)out; \
    bf16* const A_ = (bf16*)(ws + WS_A); bf16* const P6_ = (bf16*)(ws + WS_P6); bf16* const G_ = (bf16*)(ws + WS_G); (void)A_; (void)P6_; (void)G_

    if (PH_ON) { PH_FRAME(); phase_convert(F, A); PH_SEAM(); } ++ph;

    for (int layer = 0; layer < 2; ++layer) {

        if (PH_ON) { PH_FRAME(); phase_norm<0>(F, A, layer == 0 ? A->in[I_X] : (const float*)out, A->in[I_MIXN] + layer * DM, A_, nullptr, A->in[I_WIN] + (size_t)layer * DM * PTOT + 6144, PTOT, A->in[I_BF] + layer * 8); PH_SEAM(); } ++ph;
        if (PH_ON) { PH_FRAME(); pg8::Gemm g{A_, (const bf16*)(ws + WS_WIN) + (size_t)layer * NPROJ * DM, MTOK, NPROJ, DM}; pg8::StaticOrder S; S.init(MTOK, NPROJ, F.G, (int)blockIdx.x);
            pg8::EpiInProj E{P6_, G_, MTOK};
            pg8::gemm_phase<pg8::EpiInProj, pg8::StaticOrder, true, true>(F.lds, g, S, E); PH_SEAM(); } ++ph;
        if (PH_ON) { PH_FRAME(); phase_conv(F, A, A->in[I_CONVW] + layer * 3 * DCONV, layer); PH_SEAM(); } ++ph;
        if (PH_ON) { { PH_FRAME(); phase_attn(F, A, (char*)lds_raw, layer); }
            PH_FRAME(); pg8::Gemm g{P6_, (const bf16*)(ws + WS_WCO) + (size_t)layer * DM * 1024, MTOK, DM, 1024}; pg8::StaticOrder S; S.init(MTOK, DM, F.G, (int)blockIdx.x);
            pg8::EpiMerge<0> E{G_, A_};
            pg8::gemm_phase<pg8::EpiMerge<0>, pg8::StaticOrder, true, true>(F.lds, g, S, E); PH_SEAM(); } ++ph;
        if (PH_ON) { PH_FRAME(); pg8::Gemm g{P6_ + (size_t)3 * MTOK * 1024, (const bf16*)(ws + WS_WAO) + (size_t)layer * DM * 1024, MTOK, DM, 1024}; pg8::StaticOrder S; S.init(MTOK, DM, F.G, (int)blockIdx.x);
            pg8::EpiMerge<1> E{G_ + 2048, A_};
            pg8::gemm_phase<pg8::EpiMerge<1>, pg8::StaticOrder, true, true>(F.lds, g, S, E); PH_SEAM(); } ++ph;
        if (PH_ON) { PH_FRAME(); pg8::Gemm g{A_, (const bf16*)(ws + WS_WO) + (size_t)layer * DM * DM, MTOK, DM, DM}; pg8::StaticOrder S; S.init(MTOK, DM, F.G, (int)blockIdx.x);
            pg8::EpiResid E{layer == 0 ? A->in[I_X] : (const float*)out, out};
            pg8::gemm_phase<pg8::EpiResid, pg8::StaticOrder, true, true>(F.lds, g, S, E); PH_SEAM(); } ++ph;
        if (layer == 0) {
            if (PH_ON) { PH_FRAME(); phase_norm<1>(F, A, out, A->in[I_FFNN], A_, nullptr, nullptr, 0, nullptr); PH_SEAM(); } ++ph;
            if (PH_ON) { PH_FRAME(); pg8::Gemm g{A_, (const bf16*)(ws + WS_WGU), MTOK, 2 * DFF, DM}; pg8::StaticOrder S; S.init(MTOK, 2 * DFF, F.G, (int)blockIdx.x);
                pg8::EpiSwiGLU E{(bf16*)(ws + WS_HID), DFF};
                pg8::gemm_phase<pg8::EpiSwiGLU, pg8::StaticOrder, true, true>(F.lds, g, S, E); PH_SEAM(); } ++ph;
            if (PH_ON) { PH_FRAME(); pg8::Gemm g{(const bf16*)(ws + WS_HID), (const bf16*)(ws + WS_WDD), MTOK, DM, DFF}; pg8::StaticOrder S; S.init(MTOK, DM, F.G, (int)blockIdx.x);
                pg8::EpiResid E{out, out};
                pg8::gemm_phase<pg8::EpiResid, pg8::StaticOrder, true, true>(F.lds, g, S, E); PH_SEAM(); } ++ph;
        } else {
            if (PH_ON) { PH_FRAME(); phase_norm<2>(F, A, out, A->in[I_FFNN] + DM, A_, nullptr, A->in[I_RW], 8, A->in[I_RB]); PH_SEAM(); } ++ph;
            if (PH_ON) { PH_FRAME(); phase_route(F, A); PH_SEAM(); } ++ph;
            for (int rank = 0; rank < 2; ++rank) {
                if (rank == 1) { if (PH_ON) { PH_FRAME(); phase_gather(F, A, 1); PH_SEAM(); } ++ph; }
                if (PH_ON) { PH_FRAME(); int nt; moe_tile_table(F, A, rank, nt);
                    pg8::Gemm g{(const bf16*)(ws + WS_XG), (const bf16*)(ws + WS_MWGU), nt * 256, 2 * DFFE, DM}; pg8::MoeOrder S; S.init(nt * 256, 2 * DFFE, F.G, (int)blockIdx.x);
                    S.tile_e = (const LAS int*)(F.lds + TILE_E_OFF); S.estride = (size_t)2 * DFFE * DM * 2;
                    pg8::EpiSwiGLU E{(bf16*)(ws + WS_HID), DFFE};
                    pg8::gemm_phase<pg8::EpiSwiGLU, pg8::MoeOrder, true, true>(F.lds, g, S, E); PH_SEAM(); } ++ph;
                if (PH_ON) { PH_FRAME(); int nt; moe_tile_table(F, A, rank, nt);
                    pg8::Gemm g{(const bf16*)(ws + WS_HID), (const bf16*)(ws + WS_MWD), nt * 256, DM, DFFE}; pg8::MoeOrder S; S.init(nt * 256, DM, F.G, (int)blockIdx.x);
                    S.tile_e = (const LAS int*)(F.lds + TILE_E_OFF); S.estride = (size_t)DM * DFFE * 2;
                    pg8::EpiMoeDown E{(const int*)(ws + WS_ROWTOK) + rank * RMAX, (const float*)(ws + WS_ROWW) + rank * RMAX, out};
                    pg8::gemm_phase<pg8::EpiMoeDown, pg8::MoeOrder, true, true>(F.lds, g, S, E); PH_SEAM(); } ++ph;
            }
        }
    }
    if (PH_ON) { PH_FRAME(); phase_norm<3>(F, A, out, A->in[I_FN], nullptr, out, nullptr, 0, nullptr); } ++ph;
#undef PH_ON
#undef PH_SEAM
#undef PH_FRAME
}
constexpr int N_PHASES = 1 + 6 + 3 + 6 + 2 + 1 + 2 * 2 + 1;

extern "C" void kernel_launch(void* const* d_in, const int* in_sizes, int n_in, void* d_out, int out_size, void* d_ws, size_t ws_size, hipStream_t stream) {
    static int grid = 0;
    if (grid == 0) {
        if (n_in != N_IN || in_sizes[0] != MTOK * DM || out_size != MTOK * DM || ws_size < WS_END) { fprintf(stderr, "kernel_launch: shape/workspace mismatch (n_in %d, ws %zu, need %zu); nothing launched\n", n_in, ws_size, (size_t)WS_END); grid = -1; return; }
        int dev = 0, cus = 0, per_cu = 0;
        if (hipGetDevice(&dev) != hipSuccess || hipDeviceGetAttribute(&cus, hipDeviceAttributeMultiprocessorCount, dev) != hipSuccess) { grid = -1; return; }
        if (hipFuncSetAttribute((const void*)fwd, hipFuncAttributeMaxDynamicSharedMemorySize, LDS_BYTES) != hipSuccess) { fprintf(stderr, "kernel_launch: hipFuncSetAttribute failed\n"); grid = -1; return; }
        if (hipOccupancyMaxActiveBlocksPerMultiprocessor(&per_cu, (const void*)fwd, NWAVES * 64, LDS_BYTES) != hipSuccess || per_cu < 1) { fprintf(stderr, "kernel_launch: occupancy query says %d\n", per_cu); grid = -1; (void)hipGetLastError(); return; }
        grid = cus;
        if (MTOK % (grid * NWAVES) != 0) { fprintf(stderr, "kernel_launch: grid %d does not divide the token rows\n", grid); grid = -1; return; }
    }
    if (grid < 0) return;
    if (hipMemsetAsync((char*)d_ws + WS_CTL, 0, CTL_ZERO_BYTES, stream) != hipSuccess) return;
    Args ka; memset(&ka, 0, sizeof(ka));
    for (int i = 0; i < N_IN; ++i) ka.in[i] = (const float*)d_in[i];
    ka.out = (float*)d_out; ka.ws = (unsigned char*)d_ws;
#if MK_PER_PHASE
    for (int p = 0; p < N_PHASES; ++p) { ka.ph_lo = p; ka.ph_hi = p + 1; hipLaunchKernelGGL(fwd, dim3(grid), dim3(NWAVES * 64), LDS_BYTES, stream, ka); }
#else
    ka.ph_lo = 0; ka.ph_hi = N_PHASES; hipLaunchKernelGGL(fwd, dim3(grid), dim3(NWAVES * 64), LDS_BYTES, stream, ka);
#endif
}
```

```cpp
#include <hip/hip_runtime.h>
#include <cstdio>
#include <cstdint>
#include <cstring>
namespace pg8 {
#define PG8_LAS __attribute__((address_space(3)))
typedef unsigned short bf16_t;
typedef short bf16x8 __attribute__((ext_vector_type(8)));
typedef float f32x4 __attribute__((ext_vector_type(4)));
typedef unsigned u32x4 __attribute__((ext_vector_type(4)));
constexpr int BM = 256, BK = 64, HALF = 128, HTB = HALF * BK * 2  , STAGE_BYTES = 8 * HTB, NXCD = 8, WGM = 8;

__host__ __device__ __forceinline__ int lds_byte(int r, int c) { const int st = (r >> 4) * 2 + (c >> 5), rr = r & 15, cc = c & 31, ob = rr * 64 + cc * 2; return st * 1024 + (ob ^ (((ob >> 9) & 1) << 5)); }
__host__ __device__ __forceinline__ void stage_rc(int b, int& R, int& C) { const int st = b / 1024, sb = b % 1024, swz = sb ^ (((sb >> 9) & 1) << 5); R = (st >> 1) * 16 + swz / 64; C = (st & 1) * 32 + (swz % 64) / 2; }
__host__ __device__ __forceinline__ int perm32(int rho) { const int n = rho >> 4, i = rho & 15; return 8 * (i >> 2) + 4 * n + (i & 3); }

__device__ __forceinline__ int opaque_tid(int wave_sgpr) { int l; asm volatile("v_mbcnt_lo_u32_b32 %0, -1, 0\n\tv_mbcnt_hi_u32_b32 %0, -1, %0" : "=v"(l)); return (wave_sgpr << 6) | l; }
typedef int i32x8 __attribute__((ext_vector_type(8)));
typedef int i32x4 __attribute__((ext_vector_type(4)));
__device__ __forceinline__ i32x8 cat8(bf16x8 lo, bf16x8 hi) { const i32x4 a = __builtin_bit_cast(i32x4, lo), b = __builtin_bit_cast(i32x4, hi); return __builtin_shufflevector(a, b, 0, 1, 2, 3, 4, 5, 6, 7); }
struct Unit { int pm, pn; };
struct Gemm { const bf16_t* A; const bf16_t* Bt; int M, N, K; };

struct StaticOrder {
    int nM, nN, nwg, G, c;
    __host__ __device__ void init(int M, int N, int G_, int c_) { nM = M / BM; nN = N / BM; nwg = nM * nN; G = G_; c = c_; }
    __host__ __device__ bool next(int i, Unit& u) const {
        const long L = (long)i * G + c; if (L >= nwg) return false;
        int wgid = (int)L; { const int q = nwg / NXCD, r = nwg % NXCD, xcd = wgid % NXCD, off = wgid / NXCD; wgid = (xcd < r ? xcd * (q + 1) : r * (q + 1) + (xcd - r) * q) + off; }
        const int nig = WGM * nN, gid = wgid / nig, fm = gid * WGM, gsz = (nM - fm) < WGM ? (nM - fm) : WGM;
        u.pm = fm + ((wgid % nig) % gsz); u.pn = (wgid % nig) / gsz; return true;
    }
    __device__ __forceinline__ void a_ready(const Unit&) const {}
    __device__ __forceinline__ void done(const Unit&) const {}
    __device__ __forceinline__ const char* bbase(const Gemm& g, const Unit&) const { return (const char*)g.Bt; }
};
__device__ __forceinline__ unsigned cvt_pk_bf16(float lo, float hi) { unsigned r; asm volatile("v_cvt_pk_bf16_f32 %0, %1, %2" : "=v"(r) : "v"(lo), "v"(hi)); return r; }
typedef float f32x2 __attribute__((ext_vector_type(2)));
__device__ __forceinline__ float sigm(float x) { return __builtin_amdgcn_rcpf(1.0f + __builtin_amdgcn_exp2f(-1.4426950408889634f * x)); }
__device__ __forceinline__ float bf_lo(unsigned w) { return __uint_as_float(w << 16); }
__device__ __forceinline__ float bf_hi(unsigned w) { return __uint_as_float(w & 0xffff0000u); }

struct EpiInProj {
    static constexpr bool PERM = true, AFTER_DRAIN = false;
    bf16_t* P6; bf16_t* Gt; int M;
    __device__ __forceinline__ void operator()(const f32x4 (&acc)[2][2][4][2], const Unit& u, int wr, int wc, int fr, int fq) const {
        const int row0 = u.pm * BM + wr * 64 + fr; const int colt = u.pn * BM; const int t = colt >> 10; const bool gate = t >= 6;
        bf16_t* base = gate ? Gt + (colt - 6144) : P6 + (size_t)t * M * 1024 + (colt & 1023);
        const int ldc = gate ? 4096 : 1024; const int col0 = wc * 32 + 8 * fq;
#pragma unroll
        for (int ai = 0; ai < 2; ++ai)
#pragma unroll
            for (int m = 0; m < 4; ++m) { bf16_t* rowp = base + (size_t)(row0 + ai * HALF + m * 16) * ldc + col0;
#pragma unroll
                for (int bj = 0; bj < 2; ++bj) { f32x4 v0 = acc[ai][bj][m][0], v1 = acc[ai][bj][m][1];
                    if (gate) {
#pragma unroll
                        for (int j = 0; j < 4; ++j) { v0[j] = sigm(v0[j]); v1[j] = sigm(v1[j]); } }
                    u32x4 w; w.x = cvt_pk_bf16(v0[0], v0[1]); w.y = cvt_pk_bf16(v0[2], v0[3]); w.z = cvt_pk_bf16(v1[0], v1[1]); w.w = cvt_pk_bf16(v1[2], v1[3]);
                    *(u32x4*)(rowp + bj * HALF) = w; } }
    }
};
template <int MODE> struct EpiMerge {
    static constexpr bool PERM = true, AFTER_DRAIN = false;
    const bf16_t* Gt; bf16_t* Mb;
    __device__ __forceinline__ void operator()(const f32x4 (&acc)[2][2][4][2], const Unit& u, int wr, int wc, int fr, int fq) const {
        const int row0 = u.pm * BM + wr * 64 + fr; const int col0 = u.pn * BM + wc * 32 + 8 * fq;
#pragma unroll
        for (int ai = 0; ai < 2; ++ai)
#pragma unroll
            for (int m = 0; m < 4; ++m) { const size_t r = (size_t)(row0 + ai * HALF + m * 16); const bf16_t* gp = Gt + r * 4096 + col0; bf16_t* mp = Mb + r * 2048 + col0;
#pragma unroll
                for (int bj = 0; bj < 2; ++bj) { const u32x4 gw = *(const u32x4*)(gp + bj * HALF); const f32x4 a0 = acc[ai][bj][m][0], a1 = acc[ai][bj][m][1];
                    f32x4 v0, v1;
                    v0[0] = bf_lo(gw.x) * a0[0]; v0[1] = bf_hi(gw.x) * a0[1]; v0[2] = bf_lo(gw.y) * a0[2]; v0[3] = bf_hi(gw.y) * a0[3];
                    v1[0] = bf_lo(gw.z) * a1[0]; v1[1] = bf_hi(gw.z) * a1[1]; v1[2] = bf_lo(gw.w) * a1[2]; v1[3] = bf_hi(gw.w) * a1[3];
                    if (MODE == 1) { const u32x4 mw = *(const u32x4*)(mp + bj * HALF);
                        v0[0] += bf_lo(mw.x); v0[1] += bf_hi(mw.x); v0[2] += bf_lo(mw.y); v0[3] += bf_hi(mw.y);
                        v1[0] += bf_lo(mw.z); v1[1] += bf_hi(mw.z); v1[2] += bf_lo(mw.w); v1[3] += bf_hi(mw.w); }
                    u32x4 w; w.x = cvt_pk_bf16(v0[0], v0[1]); w.y = cvt_pk_bf16(v0[2], v0[3]); w.z = cvt_pk_bf16(v1[0], v1[1]); w.w = cvt_pk_bf16(v1[2], v1[3]);
                    *(u32x4*)(mp + bj * HALF) = w; } }
    }
};
struct EpiResid {
    static constexpr bool PERM = false, AFTER_DRAIN = false;
    const float* base; float* out;
    __device__ __forceinline__ void operator()(const f32x4 (&acc)[2][2][4][2], const Unit& u, int wr, int wc, int fr, int fq) const {
        const int row0 = u.pm * BM + wr * 64 + fr, col0 = u.pn * BM + wc * 32 + 4 * fq;
#pragma unroll
        for (int ai = 0; ai < 2; ++ai)
#pragma unroll
            for (int m = 0; m < 4; ++m) { const size_t off = (size_t)(row0 + ai * HALF + m * 16) * 2048 + col0;
#pragma unroll
                for (int bj = 0; bj < 2; ++bj)
#pragma unroll
                    for (int n = 0; n < 2; ++n) { const f32x4 bs = *(const f32x4*)(base + off + bj * HALF + n * 16); *(f32x4*)(out + off + bj * HALF + n * 16) = bs + acc[ai][bj][m][n]; }
                asm volatile("" ::: "memory"); }
    }
};
struct EpiSwiGLU {
    static constexpr bool PERM = true, AFTER_DRAIN = false;
    bf16_t* H; int ldh;
    __device__ __forceinline__ void operator()(const f32x4 (&acc)[2][2][4][2], const Unit& u, int wr, int wc, int fr, int fq) const {
        const int row0 = u.pm * BM + wr * 64 + fr; const int col0 = u.pn * HALF + wc * 32 + 8 * fq;
#pragma unroll
        for (int ai = 0; ai < 2; ++ai)
#pragma unroll
            for (int m = 0; m < 4; ++m) { bf16_t* rowp = H + (size_t)(row0 + ai * HALF + m * 16) * ldh + col0;
                const f32x4 g0 = acc[ai][0][m][0], g1 = acc[ai][0][m][1], u0 = acc[ai][1][m][0], u1 = acc[ai][1][m][1]; f32x4 v0, v1;
#pragma unroll
                for (int j = 0; j < 4; ++j) { v0[j] = g0[j] * sigm(g0[j]) * u0[j]; v1[j] = g1[j] * sigm(g1[j]) * u1[j]; }
                u32x4 w; w.x = cvt_pk_bf16(v0[0], v0[1]); w.y = cvt_pk_bf16(v0[2], v0[3]); w.z = cvt_pk_bf16(v1[0], v1[1]); w.w = cvt_pk_bf16(v1[2], v1[3]);
                *(u32x4*)rowp = w; }
    }
};
constexpr float F8_XS = 16.f, F8_WS = 256.f, F8_HS = 8.f;
__device__ __forceinline__ float clamp448(float x) { return __builtin_amdgcn_fmed3f(x, -448.f, 448.f); }
__device__ __forceinline__ unsigned pk4_fp8(float a, float b, float c, float d) { unsigned w = 0u; w = (unsigned)__builtin_amdgcn_cvt_pk_fp8_f32(clamp448(a), clamp448(b), (int)w, false); w = (unsigned)__builtin_amdgcn_cvt_pk_fp8_f32(clamp448(c), clamp448(d), (int)w, true); return w; }
struct EpiSwiGLU8 {
    static constexpr bool PERM = true, AFTER_DRAIN = false;
    unsigned char* H; int ldh;
    __device__ __forceinline__ void operator()(const f32x4 (&acc)[2][2][4][2], const Unit& u, int wr, int wc, int fr, int fq) const {
        const int row0 = u.pm * BM + wr * 64 + fr; const int col0 = u.pn * HALF + wc * 32 + 8 * fq; constexpr float INV = 1.0f / (F8_XS * F8_WS);
#pragma unroll
        for (int ai = 0; ai < 2; ++ai)
#pragma unroll
            for (int m = 0; m < 4; ++m) { unsigned char* rowp = H + (size_t)(row0 + ai * HALF + m * 16) * ldh + col0;
                const f32x4 g0 = acc[ai][0][m][0] * INV, g1 = acc[ai][0][m][1] * INV, u0 = acc[ai][1][m][0] * (INV * F8_HS), u1 = acc[ai][1][m][1] * (INV * F8_HS); f32x4 v0, v1;
#pragma unroll
                for (int j = 0; j < 4; ++j) { v0[j] = g0[j] * sigm(g0[j]) * u0[j]; v1[j] = g1[j] * sigm(g1[j]) * u1[j]; }
                uint2 w; w.x = pk4_fp8(v0[0], v0[1], v0[2], v0[3]); w.y = pk4_fp8(v1[0], v1[1], v1[2], v1[3]);
                *(uint2*)rowp = w; }
    }
};
struct EpiMoeDown {
    static constexpr bool PERM = false, AFTER_DRAIN = false;
    const int* row_tok; const float* row_w; float* h; float oscale;
    __device__ __forceinline__ void operator()(const f32x4 (&acc)[2][2][4][2], const Unit& u, int wr, int wc, int fr, int fq) const {
        const int rloc = u.pm * BM + wr * 64 + fr, col0 = u.pn * BM + wc * 32 + 4 * fq;
#pragma unroll
        for (int ai = 0; ai < 2; ++ai)
#pragma unroll
            for (int m = 0; m < 4; ++m) { const int r = rloc + ai * HALF + m * 16; const int tok = row_tok[r]; const float w = row_w[r] * oscale;
                if (tok >= 0) { float* p = h + (size_t)tok * 2048 + col0;
#pragma unroll
                    for (int bj = 0; bj < 2; ++bj)
#pragma unroll
                        for (int n = 0; n < 2; ++n) { const f32x4 bs = *(const f32x4*)(p + bj * HALF + n * 16); *(f32x4*)(p + bj * HALF + n * 16) = bs + w * acc[ai][bj][m][n]; } }
                asm volatile("" ::: "memory"); }
    }
};
struct MoeOrder : StaticOrder {
    const PG8_LAS int* tile_e; size_t estride;
    __device__ __forceinline__ const char* bbase(const Gemm& g, const Unit& u) const { return (const char*)g.Bt + (size_t)__builtin_amdgcn_readfirstlane(tile_e[u.pm]) * estride; }
};
template <class Epi, class Sched, bool ALIGN_EPI = false, bool SP2 = false, bool FP8 = false>
__device__ __forceinline__ void gemm_phase(PG8_LAS unsigned char* lds, const Gemm g, const Sched& S, const Epi& E, const int tid_in  ) {
    const int tid = tid_in, wid = __builtin_amdgcn_readfirstlane(tid >> 6), lane = tid & 63, wr = wid >> 2, wc = wid & 3, fr = lane & 15, fq = lane >> 4;
    const int K = FP8 ? g.K / 2 : g.K  , nt = K / BK;
    unsigned voffA[2], voffB[2];
#pragma unroll
    for (int i = 0; i < 2; ++i) { int R, C; stage_rc(tid * 16 + i * 8192, R, C); const int Rb = Epi::PERM ? ((R & ~31) + perm32(R & 31)) : R;
        const int Cb = FP8 ? 16 * (2 * ((C & 31) >> 3) + (C >> 5)) : C * 2;
        voffA[i] = (unsigned)(R * K) * 2u + (unsigned)Cb; voffB[i] = (unsigned)(Rb * K) * 2u + (unsigned)Cb; }
    const size_t kstep = (size_t)(BK * 2);
    const size_t hstep = (size_t)HALF * K * 2;
    const size_t tstep = 2 * hstep;
    const unsigned ldsw = (unsigned)wid * 1024u;
    const int aoff = lds_byte(wr * 64 + fr, fq * 8), boff = lds_byte(wc * 32 + fr, fq * 8);
#define PG8_SA(b, h) (((b) * 2 + (h)) * HTB)
#define PG8_SB(b, h) ((4 + (b) * 2 + (h)) * HTB)
#define PG8_STAGE(bufoff, gbase, voff) do { _Pragma("unroll") for (int _i = 0; _i < 2; ++_i) \
        __builtin_amdgcn_global_load_lds((const unsigned*)((const char*)(gbase) + (voff)[_i]), (PG8_LAS unsigned*)(lds + (bufoff) + ldsw + _i * 8192), 16, 0, 0); } while (0)
#define PG8_LDA(dst, b, h) do { _Pragma("unroll") for (int m = 0; m < 4; ++m) _Pragma("unroll") for (int k = 0; k < 2; ++k) dst[m][k] = *(const PG8_LAS bf16x8*)(lds + PG8_SA(b, h) + aoff + m * 2048 + k * 1024); } while (0)
#define PG8_LDB(dst, b, h) do { _Pragma("unroll") for (int n = 0; n < 2; ++n) _Pragma("unroll") for (int k = 0; k < 2; ++k) dst[n][k] = *(const PG8_LAS bf16x8*)(lds + PG8_SB(b, h) + boff + n * 2048 + k * 1024); } while (0)
#define PG8_MMA(ai, bj, At, Bt) do { __builtin_amdgcn_s_setprio(1); if constexpr (FP8) { _Pragma("unroll") for (int m = 0; m < 4; ++m) _Pragma("unroll") for (int n = 0; n < 2; ++n) \
        asm("v_mfma_f32_16x16x128_f8f6f4 %0, %1, %2, %0" : "+v"(acc[ai][bj][m][n]) : "v"(cat8(Bt[n][0], Bt[n][1])), "v"(cat8(At[m][0], At[m][1]))); }   \
      else { _Pragma("unroll") for (int m = 0; m < 4; ++m) _Pragma("unroll") for (int n = 0; n < 2; ++n) _Pragma("unroll") for (int k = 0; k < 2; ++k) \
        acc[ai][bj][m][n] = __builtin_amdgcn_mfma_f32_16x16x32_bf16(Bt[n][k], At[m][k], acc[ai][bj][m][n], 0, 0, 0); } __builtin_amdgcn_s_setprio(0); } while (0)
#define PG8_WAIT_V(n) asm volatile("s_waitcnt vmcnt(" #n ")" ::: "memory")
#define PG8_WAIT_L(n) asm volatile("s_waitcnt lgkmcnt(" #n ")" ::: "memory")
#define PG8_BAR __builtin_amdgcn_s_barrier()
#define PG8_SCHED __builtin_amdgcn_sched_barrier(0)
    Unit cur, nxt; int ui = 0;
    if (!S.next(0, cur)) return;
    f32x4 acc[2][2][4][2];
#pragma unroll
    for (int a = 0; a < 2; ++a)
#pragma unroll
        for (int b = 0; b < 2; ++b)
#pragma unroll
            for (int m = 0; m < 4; ++m)
#pragma unroll
                for (int n = 0; n < 2; ++n) acc[a][b][m][n] = (f32x4){0.f, 0.f, 0.f, 0.f};
    bf16x8 At[4][2], B0[2][2], B1[2][2];
    const char* cA = (const char*)g.A + (size_t)cur.pm * tstep; const char* cB = S.bbase(g, cur) + (size_t)cur.pn * tstep;
    S.a_ready(cur);
    if constexpr (SP2) {
        PG8_STAGE(PG8_SB(0, 0), cB, voffB); PG8_STAGE(PG8_SB(0, 1), cB + hstep, voffB); PG8_STAGE(PG8_SA(0, 0), cA, voffA); PG8_STAGE(PG8_SA(0, 1), cA + hstep, voffA);
        if (wr == 1) PG8_BAR;
        PG8_WAIT_V(2); PG8_BAR;
        PG8_STAGE(PG8_SB(1, 0), cB + kstep, voffB); PG8_STAGE(PG8_SA(1, 0), cA + kstep, voffA); PG8_STAGE(PG8_SB(1, 1), cB + hstep + kstep, voffB);
        PG8_WAIT_V(6); PG8_BAR;
    } else {
        PG8_STAGE(PG8_SB(0, 0), cB, voffB); PG8_STAGE(PG8_SA(0, 0), cA, voffA); PG8_STAGE(PG8_SB(0, 1), cB + hstep, voffB); PG8_STAGE(PG8_SA(0, 1), cA + hstep, voffA);
        if (wr == 1) PG8_BAR;
        PG8_WAIT_V(4); PG8_BAR;
        PG8_STAGE(PG8_SB(1, 0), cB + kstep, voffB); PG8_STAGE(PG8_SA(1, 0), cA + kstep, voffA); PG8_STAGE(PG8_SB(1, 1), cB + hstep + kstep, voffB);
        PG8_WAIT_V(6); PG8_BAR;
    }
    for (;;) {
        const bool has_next = S.next(ui + 1, nxt);
        const char* nA = has_next ? (const char*)g.A + (size_t)nxt.pm * tstep : cA; const char* nB = has_next ? S.bbase(g, nxt) + (size_t)nxt.pn * tstep : cB;
        for (int t = 0; t < nt; t += 2) {
            const bool last = (t == nt - 2);
            const char* a1 = cA + (size_t)(t + 1) * kstep;
            const char* a2 = last ? nA : cA + (size_t)(t + 2) * kstep; const char* b2 = last ? nB : cB + (size_t)(t + 2) * kstep;
            const char* a3 = a2 + kstep; const char* b3 = b2 + kstep;
            if (last && has_next) S.a_ready(nxt);
            if constexpr (SP2) {
            PG8_LDB(B0, 0, 0); PG8_LDB(B1, 0, 1); PG8_SCHED; PG8_LDA(At, 0, 0); PG8_STAGE(PG8_SA(1, 1), a1 + hstep, voffA);
            PG8_WAIT_V(8); PG8_WAIT_L(0); PG8_BAR; PG8_MMA(0, 0, At, B0); PG8_MMA(0, 1, At, B1); PG8_BAR; PG8_SCHED;
            PG8_LDA(At, 0, 1); PG8_STAGE(PG8_SB(0, 0), b2, voffB); PG8_STAGE(PG8_SB(0, 1), b2 + hstep, voffB); PG8_STAGE(PG8_SA(0, 0), a2, voffA);
            PG8_WAIT_V(8); PG8_WAIT_L(0); PG8_BAR; PG8_MMA(1, 0, At, B0); PG8_MMA(1, 1, At, B1); PG8_BAR; PG8_SCHED;
            PG8_LDB(B0, 1, 0); PG8_LDB(B1, 1, 1); PG8_SCHED; PG8_LDA(At, 1, 0); PG8_STAGE(PG8_SA(0, 1), a2 + hstep, voffA);
            PG8_WAIT_V(8); PG8_WAIT_L(0); PG8_BAR; PG8_MMA(0, 0, At, B0); PG8_MMA(0, 1, At, B1); PG8_BAR; PG8_SCHED;
            PG8_LDA(At, 1, 1); PG8_STAGE(PG8_SB(1, 0), b3, voffB); PG8_STAGE(PG8_SB(1, 1), b3 + hstep, voffB); PG8_STAGE(PG8_SA(1, 0), a3, voffA);
            PG8_WAIT_V(8); PG8_WAIT_L(0); PG8_BAR; PG8_MMA(1, 0, At, B0); PG8_MMA(1, 1, At, B1); PG8_BAR; PG8_SCHED;
            } else {
            PG8_LDB(B0, 0, 0); PG8_SCHED; PG8_LDA(At, 0, 0); PG8_STAGE(PG8_SA(1, 1), a1 + hstep, voffA);
            PG8_WAIT_L(8); PG8_BAR; PG8_WAIT_L(0); PG8_MMA(0, 0, At, B0); PG8_BAR; PG8_SCHED;
            PG8_LDB(B1, 0, 1); PG8_STAGE(PG8_SB(0, 0), b2, voffB);
            PG8_BAR; PG8_WAIT_L(0); PG8_MMA(0, 1, At, B1); PG8_BAR;
            PG8_LDA(At, 0, 1); PG8_STAGE(PG8_SA(0, 0), a2, voffA);
            PG8_BAR; PG8_WAIT_L(0); PG8_MMA(1, 0, At, B0); PG8_BAR; PG8_SCHED;
            PG8_STAGE(PG8_SB(0, 1), b2 + hstep, voffB);
            PG8_WAIT_V(6); PG8_BAR; PG8_MMA(1, 1, At, B1); PG8_BAR;
            PG8_LDB(B0, 1, 0); PG8_SCHED; PG8_LDA(At, 1, 0); PG8_STAGE(PG8_SA(0, 1), a2 + hstep, voffA);
            PG8_WAIT_L(8); PG8_BAR; PG8_WAIT_L(0); PG8_MMA(0, 0, At, B0); PG8_BAR; PG8_SCHED;
            PG8_LDB(B1, 1, 1); PG8_STAGE(PG8_SB(1, 0), b3, voffB);
            PG8_BAR; PG8_WAIT_L(0); PG8_MMA(0, 1, At, B1); PG8_BAR;
            PG8_LDA(At, 1, 1); PG8_STAGE(PG8_SA(1, 0), a3, voffA);
            PG8_BAR; PG8_WAIT_L(0); PG8_MMA(1, 0, At, B0); PG8_BAR; PG8_SCHED;
            PG8_STAGE(PG8_SB(1, 1), b3 + hstep, voffB);
            PG8_WAIT_V(6); PG8_BAR; PG8_MMA(1, 1, At, B1); PG8_BAR;
            }
        }
        if constexpr (ALIGN_EPI) { if (wr == 0) PG8_BAR; }
        if constexpr (FP8) asm volatile("s_nop 15\n\ts_nop 15" ::: "memory");
        if constexpr (!Epi::AFTER_DRAIN) { E(acc, cur, wr, wc, fr, fq); S.done(cur); }
        if (!has_next) break;
#pragma unroll
        for (int a = 0; a < 2; ++a)
#pragma unroll
            for (int b = 0; b < 2; ++b)
#pragma unroll
                for (int m = 0; m < 4; ++m)
#pragma unroll
                    for (int n = 0; n < 2; ++n) acc[a][b][m][n] = (f32x4){0.f, 0.f, 0.f, 0.f};
        cur = nxt; cA = nA; cB = nB; ++ui;
        if constexpr (ALIGN_EPI) { if (wr == 1) PG8_BAR; }
    }
    PG8_WAIT_V(0);
    if constexpr (!ALIGN_EPI) { if (wr == 0) PG8_BAR; }
    PG8_BAR;
    if constexpr (Epi::AFTER_DRAIN) { E.fused(acc, cur, wr, wc, fr, fq, lds, wid, lane); S.done(cur); }
#undef PG8_SA
#undef PG8_SB
#undef PG8_STAGE
#undef PG8_LDA
#undef PG8_LDB
#undef PG8_MMA
#undef PG8_WAIT_V
#undef PG8_WAIT_L
#undef PG8_BAR
#undef PG8_SCHED
}
}

namespace fox {
constexpr int D = 128, PITCH = 1024;
constexpr float THR = 8.f;
constexpr bool WSKIP = false;
constexpr float INV_SCALE = 11.313708498984761f;
constexpr float SCALE = 0.08838834764831845f;
constexpr int NW = 8, QBLK = 32, KVBLK = 64, QB = NW * QBLK;
constexpr int SHM_V = KVBLK * D * 2, SHM_K = KVBLK * D * 2;
constexpr int BIAS_OFF = 2 * SHM_V + 2 * SHM_K + NW * 64 * 4;
constexpr int LDS_BYTES = BIAS_OFF + 2 * 64 * 4;

typedef unsigned short bf16;
typedef short bf16x8 __attribute__((ext_vector_type(8)));
typedef short s16x4 __attribute__((ext_vector_type(4)));
typedef float f32x16 __attribute__((ext_vector_type(16)));
typedef float f32x4 __attribute__((ext_vector_type(4)));
typedef unsigned u32x4 __attribute__((ext_vector_type(4)));
template <class A, class Bt> struct same_t { static constexpr bool v = false; };
template <class A> struct same_t<A, A> { static constexpr bool v = true; };

#define KSWZ(row, colB) ((row) * 256 + ((colB) ^ (((row) & 7) << 4)))
#define SBAR() __builtin_amdgcn_sched_barrier(0)
__device__ __forceinline__ int v_st(int k, int c) { const int kk = (k & ~0xC) | ((k & 4) << 1) | ((k & 8) >> 1); return ((kk >> 3) * 4 + (c >> 5)) * 512 + ((kk & 7) * 32 + (c & 31)) * 2; }
__device__ __forceinline__ int v_rd_base(int lane) { return ((lane & 3) << 3) | (((lane >> 2) & 3) << 6) | (((lane >> 4) & 1) << 5) | (((lane >> 5) & 1) << 8); }
constexpr int v_rd_off(int d0, int ks, int half) { return d0 * 512 + ks * 4096 + half * 2048; }
__device__ __forceinline__ int crow(int r, int hi) { return (r & 3) + 8 * (r >> 2) + 4 * hi; }
__device__ __forceinline__ unsigned cvtpk(float lo, float hi) {
    unsigned r; asm volatile("v_cvt_pk_bf16_f32 %0, %1, %2" : "=v"(r) : "v"(lo), "v"(hi)); return r;
}
__device__ __forceinline__ bf16x8 pack8(f32x4 a, f32x4 b) {
    u32x4 w = {cvtpk(a[0], a[1]), cvtpk(a[2], a[3]), cvtpk(b[0], b[1]), cvtpk(b[2], b[3])};
    return *reinterpret_cast<bf16x8*>(&w);
}
template <class T> __device__ __forceinline__ bf16x8 load8(const T* p) {
    if constexpr (same_t<T, float>::v) { return pack8(*(const f32x4*)p, *(const f32x4*)(p + 4)); }
    else { return *reinterpret_cast<const bf16x8*>(p); }
}
__device__ __forceinline__ void mask_tile(f32x16& p0, f32x16& p1, int dq, unsigned W) {
    const float NEG = -__builtin_inff();
#pragma unroll
    for (int r = 0; r < 16; ++r) {
        const int c = (r & 3) + 8 * (r >> 2);
        if ((unsigned)(dq - c) >= W) p0[r] = NEG;
        if ((unsigned)(dq - c - 32) >= W) p1[r] = NEG;
    }
}
__device__ __forceinline__ void partialSM(f32x16& p0, f32x16& p1, float& m_reg, float& mn, float& alpha) {
    float pmax = p0[0]; for (int r = 1; r < 16; ++r) pmax = fmaxf(pmax, p0[r]); for (int r = 0; r < 16; ++r) pmax = fmaxf(pmax, p1[r]);
    { auto rr = __builtin_amdgcn_permlane32_swap(__float_as_uint(pmax), __float_as_uint(pmax), false, false);
      pmax = fmaxf(__uint_as_float(rr[0]), __uint_as_float(rr[1])); }
    constexpr float C2 = 1.4426950408889634f * SCALE;
    if (__builtin_expect(__all((pmax - m_reg) * SCALE <= THR), 1)) { mn = m_reg; alpha = 1.f; }
    else { mn = fmaxf(m_reg, pmax); alpha = __builtin_amdgcn_exp2f((m_reg - mn) * C2); m_reg = mn; }
    const float mnL = -mn * C2;
    for (int r = 0; r < 16; ++r) p0[r] = fmaf(p0[r], C2, mnL); for (int r = 0; r < 16; ++r) p1[r] = fmaf(p1[r], C2, mnL);
    for (int r = 0; r < 16; ++r) p0[r] = __builtin_amdgcn_exp2f(p0[r]);
}
__device__ __forceinline__ void finishSM(f32x16& p0, f32x16& p1, float alpha, float& l_reg, bf16x8& pa0, bf16x8& pa1, bf16x8& pa2, bf16x8& pa3) {
    for (int r = 0; r < 16; ++r) p1[r] = __builtin_amdgcn_exp2f(p1[r]);
    float ps = 0; for (int r = 0; r < 16; ++r) ps += p0[r]; for (int r = 0; r < 16; ++r) ps += p1[r];
    { auto rr = __builtin_amdgcn_permlane32_swap(__float_as_uint(ps), __float_as_uint(ps), false, false);
      ps = __uint_as_float(rr[0]) + __uint_as_float(rr[1]); }
    l_reg = l_reg * alpha + ps;
#define PK4(P, B_, OUT) do { unsigned a0 = cvtpk(P[B_+0], P[B_+1]), a1 = cvtpk(P[B_+2], P[B_+3]);                          \
        unsigned b0 = cvtpk(P[B_+4], P[B_+5]), b1 = cvtpk(P[B_+6], P[B_+7]);                                             \
        auto r0 = __builtin_amdgcn_permlane32_swap(a0, b0, false, false); auto r1 = __builtin_amdgcn_permlane32_swap(a1, b1, false, false); \
        u32x4 w = {r0[0], r1[0], r0[1], r1[1]}; OUT = *reinterpret_cast<bf16x8*>(&w); } while (0)
    PK4(p0, 0, pa0); PK4(p0, 8, pa1); PK4(p1, 0, pa2); PK4(p1, 8, pa3);
#undef PK4
}
template <int KB, bool SK>
__device__ __forceinline__ void qkt(f32x16& p0, f32x16& p1, const char* K_lds, int r32, int hi, const bf16x8* qr, bool act) {
    if (SK && !act) { const float NEG = -__builtin_inff();
#pragma unroll
        for (int r = 0; r < 16; ++r) { p0[r] = NEG; p1[r] = NEG; } return; }
    { const f32x4* bb = (const f32x4*)(K_lds + 2 * SHM_K + NW * 64 * 4 + KB * 256 + hi * 16);
#pragma unroll
      for (int g = 0; g < 4; ++g) { const f32x4 t0 = bb[2 * g], t1 = bb[8 + 2 * g];
#pragma unroll
          for (int i = 0; i < 4; ++i) { p0[4 * g + i] = t0[i]; p1[4 * g + i] = t1[i]; } } }
    const char* kb[4];
#pragma unroll
    for (int dd = 0; dd < 4; ++dd) kb[dd] = K_lds + KB * SHM_K + KSWZ(r32, (dd * 16 + hi * 8) * 2);
#pragma unroll
    for (int d0 = 0; d0 < 8; ++d0) { const char* a = kb[d0 & 3] + (d0 >> 2) * 128;
        bf16x8 b0 = *reinterpret_cast<const bf16x8*>(a);
        bf16x8 b1 = *reinterpret_cast<const bf16x8*>(a + 32 * 256);
        p0 = __builtin_amdgcn_mfma_f32_32x32x16_bf16(b0, qr[d0], p0, 0, 0, 0);
        p1 = __builtin_amdgcn_mfma_f32_32x32x16_bf16(b1, qr[d0], p1, 0, 0, 0); }
}
template <int VB, bool SK>
__device__ __forceinline__ void pv_tile(f32x16* o, int vb0, bf16x8 pa0, bf16x8 pa1, bf16x8 pa2, bf16x8 pa3, bool act) {
    if (SK && !act) return;
#define TRRD(dst, off) asm volatile("ds_read_b64_tr_b16 %0, %1 offset:%2" : "=&v"(dst) : "v"(vb0), "i"(off) : "memory")
#define PV_D0(d0) do { s16x4 l0, l1, l2, l3, h0, h1, h2, h3; constexpr int b_ = VB * SHM_V + v_rd_off(d0, 0, 0);     \
        TRRD(l0, b_); TRRD(h0, b_ + 2048); TRRD(l1, b_ + 4096); TRRD(h1, b_ + 6144); TRRD(l2, b_ + 8192); TRRD(h2, b_ + 10240); TRRD(l3, b_ + 12288); TRRD(h3, b_ + 14336); \
        asm volatile("s_waitcnt lgkmcnt(0)" ::: "memory"); SBAR();                 \
        o[d0] = __builtin_amdgcn_mfma_f32_32x32x16_bf16(pa0, (bf16x8){l0[0], l0[1], l0[2], l0[3], h0[0], h0[1], h0[2], h0[3]}, o[d0], 0, 0, 0);   \
        o[d0] = __builtin_amdgcn_mfma_f32_32x32x16_bf16(pa1, (bf16x8){l1[0], l1[1], l1[2], l1[3], h1[0], h1[1], h1[2], h1[3]}, o[d0], 0, 0, 0);   \
        o[d0] = __builtin_amdgcn_mfma_f32_32x32x16_bf16(pa2, (bf16x8){l2[0], l2[1], l2[2], l2[3], h2[0], h2[1], h2[2], h2[3]}, o[d0], 0, 0, 0);   \
        o[d0] = __builtin_amdgcn_mfma_f32_32x32x16_bf16(pa3, (bf16x8){l3[0], l3[1], l3[2], l3[3], h3[0], h3[1], h3[2], h3[3]}, o[d0], 0, 0, 0); } while (0)
    PV_D0(0); PV_D0(1); PV_D0(2); PV_D0(3);
#undef PV_D0
#undef TRRD
}

template <class TIn, class TOut> struct BlockRef { const TIn* Q; const TIn* K; const TIn* V; TOut* O; const float* cb; float cref; int P0; int jlo; };
template <class TIn> struct Seam {
    bf16x8 qr[8];
    bf16x8 st_v0, st_v1, st_k0, st_k1; float st_c; f32x4 sf0, sf1, sf2, sf3;
    f32x4 tq[16];
};
__device__ __forceinline__ int swa_jlo(int P0, int W) { const int lowk = P0 - W + 1; return lowk > 0 ? lowk / KVBLK : 0; }
#define ROW(p, k0, rr) ((p) + (size_t)((k0) + (rr)) * PITCH + sc)
#define VMW() asm volatile("s_waitcnt vmcnt(0)" ::: "memory")
#define VMWN(n) asm volatile("s_waitcnt vmcnt(%0)" :: "i"(n) : "memory")
#define SLOAD_H(Kp, Vp, Cp, k0) do { S.st_v0 = load8<TIn>(ROW(Vp, k0, sr)); S.st_v1 = load8<TIn>(ROW(Vp, k0, 32 + sr));              \
                         S.st_k0 = load8<TIn>(ROW(Kp, k0, sr)); S.st_k1 = load8<TIn>(ROW(Kp, k0, 32 + sr)); S.st_c = (Cp)[(k0) + lane]; } while (0)
#define SWRITE_HK(bf, cr) do { *(bf16x8*)(K_lds + (bf) * SHM_K + kws) = S.st_k0; *(bf16x8*)(K_lds + (bf) * SHM_K + kws + 32 * 256) = S.st_k1; \
                            if (wid == 0) ((float*)(K_lds + 2 * SHM_K + NW * 64 * 4))[(bf) * 64 + lane] = ((cr) - S.st_c) * INV_SCALE; } while (0)
#define SWRITE_HV(bf) do { *(bf16x8*)(V_lds + (bf) * SHM_V + vst0) = S.st_v0; *(bf16x8*)(V_lds + (bf) * SHM_V + vst1) = S.st_v1; } while (0)
#define SWRITE_H(bf, cr) do { SWRITE_HV(bf); SWRITE_HK(bf, cr); } while (0)
#define SLOAD_F(p, k0) do { S.sf0 = *(const f32x4*)ROW(p, k0, sr); S.sf1 = *(const f32x4*)(ROW(p, k0, sr) + 4);                \
                            S.sf2 = *(const f32x4*)ROW(p, k0, 32 + sr); S.sf3 = *(const f32x4*)(ROW(p, k0, 32 + sr) + 4); } while (0)
#define SWRITE_KF(bf) do { *(bf16x8*)(K_lds + (bf) * SHM_K + kws) = pack8(S.sf0, S.sf1); *(bf16x8*)(K_lds + (bf) * SHM_K + kws + 32 * 256) = pack8(S.sf2, S.sf3); } while (0)
#define SWRITE_VF(bf) do { *(bf16x8*)(V_lds + (bf) * SHM_V + vst0) = pack8(S.sf0, S.sf1); *(bf16x8*)(V_lds + (bf) * SHM_V + vst1) = pack8(S.sf2, S.sf3); } while (0)
template <class TIn, class TOut>
__device__ __forceinline__ void causal_swa_prime(const BlockRef<TIn, TOut>& cur, int W, char* lds, Seam<TIn>& S, const int wave_in  ) {
    constexpr bool F32 = same_t<TIn, float>::v;
    const int tid = pg8::opaque_tid(wave_in), wid = __builtin_amdgcn_readfirstlane(tid >> 6), lane = tid & 63, r32 = lane & 31, hi = lane >> 5;
    const int sr = tid >> 4, sc = (tid & 15) * 8, kws = KSWZ(sr, sc * 2); char* K_lds = lds + 2 * SHM_V;
    const int kb0 = cur.jlo * KVBLK;
    for (int d0 = 0; d0 < 8; ++d0) S.qr[d0] = load8<TIn>(cur.Q + (size_t)(wid * QBLK + r32) * PITCH + d0 * 16 + hi * 8);
    if constexpr (F32) { SLOAD_F((const float*)cur.K, kb0); VMW(); SWRITE_KF(0); SBAR(); SLOAD_F((const float*)cur.V, kb0); }
    else { SLOAD_H(cur.K, cur.V, cur.cb, kb0); VMW(); SWRITE_HK(0, cur.cref); }
    __syncthreads();
}
template <class TIn, class TOut>
__device__ __forceinline__ void causal_swa_block(const BlockRef<TIn, TOut>& cur, const BlockRef<TIn, TOut>& nxt, int skv, int W, char* lds, Seam<TIn>& S, const int wave_in  ) {
    constexpr bool F32 = same_t<TIn, float>::v;
    const int tid = pg8::opaque_tid(wave_in), wid = __builtin_amdgcn_readfirstlane(tid >> 6), lane = tid & 63, r32 = lane & 31, hi = lane >> 5;
    const int j_lo = cur.jlo;
    int j_hi = (cur.P0 + QB - 1) / KVBLK + 1; if (j_hi > skv / KVBLK) j_hi = skv / KVBLK;
    const int NT = j_hi - j_lo;
    const int kbn = nxt.jlo * KVBLK;
    const int qlo = cur.P0 + wid * QBLK, qm = qlo + r32 - 4 * hi;
    char* V_lds = lds; char* K_lds = lds + 2 * SHM_V;
    float* ws = (float*)(lds + 2 * SHM_V + 2 * SHM_K) + wid * 64; float* li_l = ws, * al_l = ws + 32;
    float m_reg = -1e30f, l_reg = 0; f32x16 o[4] = {};
    const int sr = tid >> 4, sc = (tid & 15) * 8, vst0 = v_st(sr, sc), vst1 = v_st(32 + sr, sc), kws = KSWZ(sr, sc * 2);
    const int vb0 = (int)(uintptr_t)V_lds + v_rd_base(lane);
    const TIn* Kh = cur.K; const TIn* Vh = cur.V;
#define RESC(a) do { if (__any((a) < 1.f)) { if (hi == 0) al_l[r32] = (a); asm volatile("s_waitcnt lgkmcnt(0)" ::: "memory");              \
                     for (int d_ = 0; d_ < 4; ++d_) for (int r = 0; r < 16; ++r) o[d_][r] *= al_l[crow(r, hi)]; } } while (0)
#define KBASE(t) ((j_lo + (t)) * KVBLK)
#define ACT(t) (KBASE(t) <= qlo + QBLK - 1 && KBASE(t) + KVBLK - 1 >= qlo - W + 1)
#define MASKT(P0_, P1_, t) do { const int kb_ = KBASE(t); if ((!SK || ACT(t)) && (kb_ + KVBLK - 1 > qlo || kb_ <= qlo + QBLK - 1 - W)) mask_tile(P0_, P1_, qm - kb_, (unsigned)W); } while (0)
    constexpr int NQL = F32 ? 16 : 8;
    constexpr bool SK = WSKIP && !F32;
#define SEAM_K0() do { VMWN(NQL); if constexpr (F32) { SWRITE_KF(0); SBAR(); SLOAD_F((const float*)nxt.V, kbn); } else { SWRITE_HK(0, nxt.cref); } SBAR(); } while (0)
    f32x16 pA0, pA1, pB0, pB1; float mnA, mnB, alA, alB; bf16x8 pa0, pa1, pa2, pa3;
    if constexpr (F32) { VMW(); SWRITE_VF(0); SBAR(); } else { SWRITE_HV(0); SBAR(); }
    if (NT > 1) { if constexpr (F32) SLOAD_F((const float*)Kh, KBASE(1)); else SLOAD_H(Kh, Vh, cur.cb, KBASE(1)); }
    SBAR(); qkt<0, SK>(pA0, pA1, K_lds, r32, hi, S.qr, ACT(0));
    if constexpr (F32) { if (NT > 1) { VMW(); SWRITE_KF(1); SBAR(); SLOAD_F((const float*)Vh, KBASE(1)); } }
    MASKT(pA0, pA1, 0); partialSM(pA0, pA1, m_reg, mnA, alA);
    if (NT > 1) { VMW(); if constexpr (F32) { SWRITE_VF(1); SBAR(); if (NT > 2) SLOAD_F((const float*)Kh, KBASE(2)); } else SWRITE_H(1, cur.cref); }
    __syncthreads();
#define HALF_STEP(PX0, PX1, mnX, alX, PY0, PY1, alY, t, KB, VB, SB) do {                                                      \
        SBAR(); qkt<KB, SK>(PX0, PX1, K_lds, r32, hi, S.qr, ACT(t));                                             \
        finishSM(PY0, PY1, alY, l_reg, pa0, pa1, pa2, pa3); SBAR();                                                           \
        if ((t) + 1 < NT) { if constexpr (F32) { VMW(); SWRITE_KF(SB); SBAR(); SLOAD_F((const float*)Vh, KBASE((t) + 1)); }  \
                            else { SLOAD_H(Kh, Vh, cur.cb, KBASE((t) + 1)); } SBAR(); }                                               \
        pv_tile<VB, SK>(o, vb0, pa0, pa1, pa2, pa3, ACT((t) - 1)); MASKT(PX0, PX1, (t)); partialSM(PX0, PX1, m_reg, mnX, alX);                                        \
        __syncthreads();                                                                                                      \
        if ((t) + 1 < NT) { VMW(); if constexpr (F32) { SWRITE_VF(SB); SBAR(); if ((t) + 2 < NT) SLOAD_F((const float*)Kh, KBASE((t) + 2)); } \
                            else { SWRITE_H(SB, cur.cref); } }                                                                          \
        RESC(alX); __syncthreads(); } while (0)
    for (int t = 1; t + 1 < NT; t += 2) {
        HALF_STEP(pB0, pB1, mnB, alB, pA0, pA1, alA, t, 1, 0, 0);
        HALF_STEP(pA0, pA1, mnA, alA, pB0, pB1, alB, t + 1, 0, 1, 1);
    }
    const bool even = (NT & 1) == 0;
    if (even) { SBAR(); qkt<1, SK>(pB0, pB1, K_lds, r32, hi, S.qr, ACT(NT - 1)); SBAR(); }
#define QROW(e) (nxt.Q + (size_t)(wid * QBLK + r32) * PITCH + ((e) >> 1) * 16 + hi * 8 + ((e) & 1) * 4)
    if constexpr (F32) { SLOAD_F((const float*)nxt.K, kbn); SBAR();
#pragma unroll
        for (int e = 0; e < 8; ++e) S.tq[e] = *(const f32x4*)QROW(e); }
    else { SLOAD_H(nxt.K, nxt.V, nxt.cb, kbn); SBAR();
#pragma unroll
        for (int d0 = 0; d0 < 8; ++d0) S.qr[d0] = load8<TIn>(nxt.Q + (size_t)(wid * QBLK + r32) * PITCH + d0 * 16 + hi * 8); }
    SBAR();
    finishSM(pA0, pA1, alA, l_reg, pa0, pa1, pa2, pa3); SBAR();
    if constexpr (F32) {
#pragma unroll
        for (int e = 8; e < 16; ++e) S.tq[e] = *(const f32x4*)QROW(e); SBAR(); }
#undef QROW
    pv_tile<0, SK>(o, vb0, pa0, pa1, pa2, pa3, ACT(even ? NT - 2 : NT - 1));
    if (even) { MASKT(pB0, pB1, NT - 1); partialSM(pB0, pB1, m_reg, mnB, alB); __syncthreads(); RESC(alB);
        finishSM(pB0, pB1, alB, l_reg, pa0, pa1, pa2, pa3); SBAR(); pv_tile<1, SK>(o, vb0, pa0, pa1, pa2, pa3, ACT(NT - 1)); }
    SBAR(); SEAM_K0();
    if (hi == 0) li_l[r32] = l_reg; asm volatile("s_waitcnt lgkmcnt(0)" ::: "memory");
    float rli[16];
#pragma unroll
    for (int r = 0; r < 16; ++r) rli[r] = __builtin_amdgcn_rcpf(li_l[crow(r, hi)]);
    TOut* Ow = cur.O + (size_t)(wid * QBLK) * PITCH;
#pragma unroll
    for (int r = 0; r < 16; ++r) { const int orow = crow(r, hi);
#pragma unroll
        for (int d0 = 0; d0 < 4; ++d0) { const float v = o[d0][r] * rli[r];
            if constexpr (same_t<TOut, float>::v) { Ow[(size_t)orow * PITCH + d0 * 32 + r32] = v; }
            else { const float vn = __int_as_float(__builtin_amdgcn_update_dpp(0, __float_as_int(v), 0xB1  , 0xF, 0xF, false));
                   if ((r32 & 1) == 0) *(unsigned*)(Ow + (size_t)orow * PITCH + d0 * 32 + r32) = cvtpk(v, vn); } } }
    if constexpr (F32) {
#pragma unroll
        for (int d0 = 0; d0 < 8; ++d0) S.qr[d0] = pack8(S.tq[2 * d0], S.tq[2 * d0 + 1]); }
    __syncthreads();
#undef RESC
#undef KBASE
#undef ACT
#undef MASKT
#undef SEAM_K0
#undef HALF_STEP
}
#undef ROW
#undef VMW
#undef VMWN
#undef SLOAD_H
#undef SWRITE_HK
#undef SWRITE_HV
#undef SWRITE_H
#undef SLOAD_F
#undef SWRITE_KF
#undef SWRITE_VF

}

#define GAS __attribute__((address_space(1)))
#define LAS __attribute__((address_space(3)))
typedef unsigned short bf16;
typedef unsigned v4u __attribute__((ext_vector_type(4)));
typedef float f32x4 __attribute__((ext_vector_type(4)));
typedef short bf16x8 __attribute__((ext_vector_type(8)));
typedef GAS unsigned gu32;
typedef GAS unsigned long long gu64;
#define RLX_AGENT __ATOMIC_RELAXED, __HIP_MEMORY_SCOPE_AGENT
#define LDS_WAIT() asm volatile("s_waitcnt lgkmcnt(0)" ::: "memory")
#define VM_WAIT() asm volatile("s_waitcnt vmcnt(0)" ::: "memory")
__device__ __forceinline__ unsigned long long rt() { return __builtin_amdgcn_s_memrealtime(); }
__device__ __forceinline__ unsigned f2bf(float f) { unsigned u = __builtin_bit_cast(unsigned, f); return (u + 0x7fffu + ((u >> 16) & 1u)) >> 16; }
__device__ __forceinline__ unsigned pk2(float lo, float hi) { return f2bf(lo) | (f2bf(hi) << 16); }

#define XB_TMO      128
#define XB_XCNT(j)  (256  + 64 * (j))
#define XB_XSUB(j)  (1280 + 64 * (j))
#define XB_XGEN(j)  (2304 + 64 * (j))
#define XB_TOP      3328
#define XB_TOPGEN   3392
#define XCD_BAR_WORDS 3456
#define XB_SPIN_CAP (1u << 21)

__device__ __forceinline__ unsigned xb_ld(unsigned* p)              { return __hip_atomic_load(p, __ATOMIC_RELAXED, __HIP_MEMORY_SCOPE_AGENT); }
__device__ __forceinline__ unsigned xb_add(unsigned* p, unsigned v) { return __hip_atomic_fetch_add(p, v, __ATOMIC_RELAXED, __HIP_MEMORY_SCOPE_AGENT); }
__device__ __forceinline__ unsigned xb_xcc_id() { return (unsigned)__builtin_amdgcn_s_getreg((3 << 11) | 20) & 0xFu; }
#define XB_SPIN(cond, bar) do { unsigned _sp = 0; while (cond) { __builtin_amdgcn_s_sleep(1); \
    if ((++_sp & 255u) == 0u) { if (xb_ld(&(bar)[XB_TMO])) break; if (_sp > XB_SPIN_CAP) { atomicAdd(&(bar)[XB_TMO], 1u); break; } } } } while (0)

struct XcdBarrier {
    unsigned* bar; unsigned x;
    volatile LAS unsigned* st;
};

__device__ __forceinline__ XcdBarrier xcd_barrier_post(unsigned* bar, volatile LAS unsigned* st) {
    XcdBarrier b; b.bar = bar; b.x = xb_xcc_id(); b.st = st;
    if (threadIdx.x == 0) (void)xb_add(&bar[XB_XCNT(b.x)], 1u);
    return b;
}
__device__ __forceinline__ void xcd_barrier_complete(unsigned* bar, unsigned x, unsigned& nloc, unsigned& nx) {
    const unsigned G = gridDim.x * gridDim.y * gridDim.z;
    unsigned sum, cnt, mine, sp = 0u;
    for (;;) {
        sum = 0u; cnt = 0u; mine = 0u;
#pragma unroll
        for (unsigned j = 0; j < 16; ++j) { const unsigned c = xb_ld(&bar[XB_XCNT(j)]); sum += c; cnt += (c > 0u) ? 1u : 0u; mine = (j == x) ? c : mine; }
        if (sum == G) break;
        __builtin_amdgcn_s_sleep(1);
        if ((++sp & 255u) == 0u) { if (xb_ld(&bar[XB_TMO])) break; if (sp > XB_SPIN_CAP) { atomicAdd(&bar[XB_TMO], 1u); break; } }
    }
    nloc = mine > 0u ? mine : 1u; nx = cnt > 0u ? cnt : 1u;
}

__device__ __forceinline__ void xcd_barrier(const XcdBarrier& b) {
    asm volatile("s_waitcnt vmcnt(0)" ::: "memory");
    __syncthreads();
    if (threadIdx.x == 0) {
        unsigned* bar = b.bar;
        __builtin_amdgcn_s_waitcnt(0);
        unsigned nloc = b.st[0], nx = b.st[1];
        if (nloc == 0u) { xcd_barrier_complete(bar, b.x, nloc, nx); b.st[0] = nloc; b.st[1] = nx; }
        const unsigned old = xb_add(&bar[XB_XSUB(b.x)], 1u);
        const unsigned gen = old / nloc;
        if (old + 1u == (gen + 1u) * nloc) {
            __builtin_amdgcn_fence(__ATOMIC_RELEASE, "agent");
            asm volatile("s_waitcnt vmcnt(0)" ::: "memory");
            const unsigned og = xb_add(&bar[XB_TOP], 1u);
            const unsigned tg = og / nx;
            if (og + 1u == (tg + 1u) * nx) xb_add(&bar[XB_TOPGEN], 1u);
            else XB_SPIN(xb_ld(&bar[XB_TOPGEN]) == tg, bar);
            __builtin_amdgcn_fence(__ATOMIC_ACQUIRE, "agent");
            xb_add(&bar[XB_XGEN(b.x)], 1u);
            asm volatile("s_waitcnt vmcnt(0)" ::: "memory");
        } else {
            XB_SPIN(xb_ld(&bar[XB_XGEN(b.x)]) == gen, bar);
            __builtin_amdgcn_fence(__ATOMIC_ACQUIRE, "agent");
            asm volatile("s_waitcnt vmcnt(0)" ::: "memory");
        }
    }
    __syncthreads();
}

constexpr int NWAVES = 8;
#ifndef MK_PER_PHASE
#define MK_PER_PHASE 0
#endif
constexpr int BATCH = 2, SEQ = 16384, DM = 2048, MTOK = BATCH * SEQ;
constexpr int DCONV = 1024, NH = 8, DATT = 1024, PTOT = 10248, NPROJ = 10240;
constexpr int DFF = 5632, NE = 8, DFFE = 7168;
constexpr int RMAX = MTOK + NE * 256;
constexpr float RMS_EPS = 1e-6f;
constexpr size_t MiB = 1u << 20;
constexpr size_t WS_CTL = 0, CTL_ZERO_BYTES = 1 * MiB;
constexpr size_t WS_LOGF = 1 * MiB;
constexpr size_t WS_CB = 2 * MiB;
constexpr size_t WS_TOKE = 3 * MiB;
constexpr size_t WS_TOKW = 3 * MiB + 512 * 1024;
constexpr size_t WS_ROWTOK = 4 * MiB;
constexpr size_t WS_ROWW = 5 * MiB;
constexpr size_t WS_WIN = 8 * MiB;
constexpr size_t WS_WCO = WS_WIN + 80 * MiB;
constexpr size_t WS_WAO = WS_WCO + 8 * MiB;
constexpr size_t WS_WO = WS_WAO + 8 * MiB;
constexpr size_t WS_WGU = WS_WO + 16 * MiB;
constexpr size_t WS_WDD = WS_WGU + 44 * MiB;
constexpr size_t WS_MWGU = WS_WDD + 22 * MiB;
constexpr size_t WS_MWD = WS_MWGU + 448 * MiB;
constexpr size_t WS_A = WS_MWD + 224 * MiB;
constexpr size_t WS_P6 = WS_A + 128 * MiB;
constexpr size_t WS_G = WS_P6 + 384 * MiB;
constexpr size_t WS_END = WS_G + 256 * MiB;
constexpr size_t WS_HID = WS_P6;
constexpr size_t WS_XG = WS_P6 + 476 * MiB;
static_assert((size_t)RMAX * DFFE * 2 <= 476 * MiB && WS_XG + (size_t)RMAX * DM * 2 <= WS_END && (size_t)MTOK * DFF * 2 <= 476 * MiB, "overlay");
static_assert((size_t)2 * NPROJ * DM * 2 == 80 * MiB && (size_t)2 * DFF * DM * 2 == 44 * MiB && (size_t)NE * 2 * DFFE * DM * 2 == 448 * MiB, "weights");
constexpr int CW_CNT = 64;
constexpr int CW_CUR = 128;
constexpr int CW_NMAX = 192;
constexpr int CW_BAR = 4096;
constexpr int RING_BYTES = 131072;
constexpr int LDSCTL_OFF = RING_BYTES, MISC_OFF = LDSCTL_OFF + 320, TILE_E_OFF = LDSCTL_OFF + 1024, JLO_OFF = LDSCTL_OFF + 2048;
constexpr float PRUNE_T = 32.f;
constexpr int LDS_BYTES = 147456;
enum { I_X = 0, I_MIXN, I_WIN, I_BF, I_CONVW, I_WCO, I_WAO, I_WO, I_FFNN, I_DWG, I_DWU, I_DWD, I_RW, I_RB, I_MWG, I_MWU, I_MWD, I_FN, N_IN };

struct Args { const float* in[N_IN]; float* out; unsigned char* ws; int ph_lo, ph_hi; };
struct Frame { LAS unsigned char* lds; int tid, lane, wave, vcu, G; };
#define KAS __attribute__((address_space(4)))
typedef const KAS Args* ArgsP;

__device__ __forceinline__ float wave_sum(float v, int lane) {
#pragma unroll
    for (int o = 1; o < 64; o <<= 1) v += __int_as_float(__builtin_amdgcn_ds_bpermute((lane ^ o) << 2, __float_as_int(v)));
    return v;
}
struct CvtJob { const float* src; bf16* dst; int ldw, col_off, ncols, K, kind, row_off, fp8; };
__device__ __forceinline__ void get_job(ArgsP a, int j, CvtJob& J) {
    J.fp8 = 0;
    if (j < 4) { const int l = j >> 1, p = j & 1; J.src = a->in[I_WIN] + (size_t)l * DM * PTOT; J.ldw = PTOT; J.col_off = p ? 6152 : 0; J.ncols = p ? 4096 : 6144; J.K = DM;
        J.dst = (bf16*)(a->ws + WS_WIN) + (size_t)l * NPROJ * DM; J.kind = 0; J.row_off = p ? 6144 : 0; }
    else if (j < 8) { const int l = j & 1, w = (j - 4) >> 1; J.src = a->in[w ? I_WAO : I_WCO] + (size_t)l * 1024 * DM; J.ldw = DM; J.col_off = 0; J.ncols = DM; J.K = 1024;
        J.dst = (bf16*)(a->ws + (w ? WS_WAO : WS_WCO)) + (size_t)l * DM * 1024; J.kind = 0; J.row_off = 0; }
    else if (j < 10) { const int l = j & 1; J.src = a->in[I_WO] + (size_t)l * DM * DM; J.ldw = DM; J.col_off = 0; J.ncols = DM; J.K = DM; J.dst = (bf16*)(a->ws + WS_WO) + (size_t)l * DM * DM; J.kind = 0; J.row_off = 0; }
    else if (j < 12) { const int u = j - 10; J.src = a->in[u ? I_DWU : I_DWG]; J.ldw = DFF; J.col_off = 0; J.ncols = DFF; J.K = DM; J.dst = (bf16*)(a->ws + WS_WGU); J.kind = 1; J.row_off = u ? 128 : 0; }
    else if (j < 13) { J.src = a->in[I_DWD]; J.ldw = DM; J.col_off = 0; J.ncols = DM; J.K = DFF; J.dst = (bf16*)(a->ws + WS_WDD); J.kind = 0; J.row_off = 0; }
    else if (j < 29) { const int e = (j - 13) & 7, u = (j - 13) >> 3; J.src = a->in[u ? I_MWU : I_MWG] + (size_t)e * DM * DFFE; J.ldw = DFFE; J.col_off = 0; J.ncols = DFFE; J.K = DM;
        J.dst = (bf16*)(a->ws + WS_MWGU + (size_t)e * 2 * DFFE * DM); J.kind = 1; J.row_off = u ? 128 : 0; J.fp8 = 1; }
    else { const int e = j - 29; J.src = a->in[I_MWD] + (size_t)e * DFFE * DM; J.ldw = DM; J.col_off = 0; J.ncols = DM; J.K = DFFE; J.dst = (bf16*)(a->ws + WS_MWD + (size_t)e * DM * DFFE); J.kind = 0; J.row_off = 0; J.fp8 = 1; }
}
constexpr int N_CVT_JOBS = 37;
__device__ __forceinline__ void cvt_item(const CvtJob& J, int item, int lane) {
    const int nblk = J.ncols >> 5, kb = item / nblk, nb = item - kb * nblk;
    const int kq = lane >> 3, n4 = lane & 7;
    const float* s = J.src + (size_t)(kb * 64 + kq * 8) * J.ldw + J.col_off + nb * 32 + n4 * 4;
    f32x4 v[8];
#pragma unroll
    for (int e = 0; e < 8; ++e) v[e] = *(const GAS f32x4*)(s + (size_t)e * J.ldw);
    const int src_lane = ((lane & 7) << 3) | (lane >> 3);
    unsigned w[4][4];
#pragma unroll
    for (int j = 0; j < 4; ++j)
#pragma unroll
        for (int q = 0; q < 4; ++q) w[j][q] = (unsigned)__builtin_amdgcn_ds_bpermute(src_lane << 2, (int)pk2(v[2 * q][j], v[2 * q + 1][j]));
    const int n0 = nb * 32 + (lane >> 3) * 4, k0 = kb * 64 + (lane & 7) * 8;
    const int drow = (J.kind == 1 ? 256 * (n0 >> 7) + (n0 & 127) : n0) + J.row_off;
#pragma unroll
    for (int j = 0; j < 4; ++j) { v4u o; o.x = w[j][0]; o.y = w[j][1]; o.z = w[j][2]; o.w = w[j][3]; *(GAS v4u*)(J.dst + (size_t)(drow + j) * J.K + k0) = o; }
}
__device__ __forceinline__ void cvt_item8(const CvtJob& J, int item, int lane) {
    const int nblk = J.ncols >> 5, kb = item / nblk, nb = item - kb * nblk;
    const int kq = lane >> 3, n4 = lane & 7;
    const float* s = J.src + (size_t)(kb * 128 + kq * 16) * J.ldw + J.col_off + nb * 32 + n4 * 4;
    f32x4 v[16];
#pragma unroll
    for (int e = 0; e < 16; ++e) v[e] = *(const GAS f32x4*)(s + (size_t)e * J.ldw);
    const int src_lane = ((lane & 7) << 3) | (lane >> 3);
    unsigned w[4][4];
#pragma unroll
    for (int j = 0; j < 4; ++j)
#pragma unroll
        for (int q = 0; q < 4; ++q) w[j][q] = (unsigned)__builtin_amdgcn_ds_bpermute(src_lane << 2, (int)pg8::pk4_fp8(v[4 * q][j] * pg8::F8_WS, v[4 * q + 1][j] * pg8::F8_WS, v[4 * q + 2][j] * pg8::F8_WS, v[4 * q + 3][j] * pg8::F8_WS));
    const int n0 = nb * 32 + (lane >> 3) * 4, k0 = kb * 128 + (lane & 7) * 16;
    const int drow = (J.kind == 1 ? 256 * (n0 >> 7) + (n0 & 127) : n0) + J.row_off;
    unsigned char* d8 = (unsigned char*)J.dst;
#pragma unroll
    for (int j = 0; j < 4; ++j) { v4u o; o.x = w[j][0]; o.y = w[j][1]; o.z = w[j][2]; o.w = w[j][3]; *(GAS v4u*)(d8 + (size_t)(drow + j) * J.K + k0) = o; }
}
__device__ __forceinline__ void phase_convert(const Frame& F, ArgsP a) {
    const int gw = F.vcu * NWAVES + F.wave, NGW = F.G * NWAVES; int off = 0;
    for (int j = 0; j < N_CVT_JOBS; ++j) { CvtJob J; get_job(a, j, J); const int nit = (J.fp8 ? (J.K >> 7) : (J.K >> 6)) * (J.ncols >> 5);
        int i0 = (gw - off) % NGW; if (i0 < 0) i0 += NGW;
        if (J.fp8) { for (int it = i0; it < nit; it += NGW) cvt_item8(J, it, F.lane); } else { for (int it = i0; it < nit; it += NGW) cvt_item(J, it, F.lane); }
        off = (off + nit) % NGW; }
}
__device__ __forceinline__ float log_sigmoid(float x) {
    const float y = __builtin_amdgcn_exp2f(-1.4426950408889634f * __builtin_fabsf(x));
    const float l1p = y < 1e-3f ? y * (1.0f - 0.5f * y) : 0.6931471805599453f * __builtin_amdgcn_logf(1.0f + y);
    return fminf(x, 0.f) - l1p;
}
__device__ __forceinline__ void stage_w8(const Frame& F, const float* w8, int ldw) {
    LAS float* wl = (LAS float*)F.lds;
    for (int col = F.tid; col < DM; col += NWAVES * 64) { const int j = col >> 8, ln = (col & 255) >> 2, e = col & 3;
        const f32x4 a = *(const GAS f32x4*)(w8 + (size_t)col * ldw), b = *(const GAS f32x4*)(w8 + (size_t)col * ldw + 4);
        LAS f32x4* d = (LAS f32x4*)(wl + ((j * 4 + e) * 64 + ln) * 8); d[0] = a; d[1] = b; }
    __syncthreads();
}
template <int MODE>
__device__ __forceinline__ void phase_norm(const Frame& F, ArgsP a, const float* hin, const float* gain, bf16* aout, float* fout, const float* w8, int ldw8, const float* b8) {
    if (MODE == 0 || MODE == 2) stage_w8(F, w8, ldw8);
    const LAS float* wl = (const LAS float*)F.lds;
    f32x4 g[8];
#pragma unroll
    for (int j = 0; j < 8; ++j) g[j] = *(const GAS f32x4*)(gain + 256 * j + 4 * F.lane);
    float bb[8];
#pragma unroll
    for (int h = 0; h < 8; ++h) bb[h] = (MODE == 0 || MODE == 2) ? b8[h] : 0.f;
    const int RPW = MTOK / (F.G * NWAVES);
    const int gw = F.vcu * NWAVES + F.wave; const int r0 = gw * RPW;
    float* logf = (float*)(a->ws + WS_LOGF); int* tokE = (int*)(a->ws + WS_TOKE); float* tokW = (float*)(a->ws + WS_TOKW);
    int mycnt = 0;
    for (int r = r0; r < r0 + RPW; ++r) {
        const GAS f32x4* xr = (const GAS f32x4*)(hin + (size_t)r * DM) + F.lane;
        f32x4 v[8]; float ss = 0.f;
#pragma unroll
        for (int j = 0; j < 8; ++j) { v[j] = xr[64 * j]; ss += (v[j].x * v[j].x + v[j].y * v[j].y) + (v[j].z * v[j].z + v[j].w * v[j].w); }
        const float rstd = 1.0f / sqrtf(wave_sum(ss, F.lane) * (1.0f / DM) + RMS_EPS);
#pragma unroll
        for (int j = 0; j < 8; ++j) v[j] = v[j] * rstd * g[j];
        if (MODE == 3) { GAS f32x4* o = (GAS f32x4*)(fout + (size_t)r * DM) + F.lane;
#pragma unroll
            for (int j = 0; j < 8; ++j) o[64 * j] = v[j]; }
        else { GAS unsigned long long* o8 = (GAS unsigned long long*)(aout + (size_t)r * DM) + F.lane;
#pragma unroll
            for (int j = 0; j < 8; ++j) o8[64 * j] = (unsigned long long)pk2(v[j].x, v[j].y) | ((unsigned long long)pk2(v[j].z, v[j].w) << 32); }
        if (MODE == 0 || MODE == 2) {
            float acc[8];
#pragma unroll
            for (int h = 0; h < 8; ++h) acc[h] = 0.f;
#pragma unroll
            for (int j = 0; j < 8; ++j) { asm volatile("" ::: "memory");
#pragma unroll
                for (int e = 0; e < 4; ++e) { const LAS f32x4* wp = (const LAS f32x4*)(wl + ((j * 4 + e) * 64 + F.lane) * 8); const f32x4 w0 = wp[0], w1 = wp[1]; const float x = v[j][e];
                    acc[0] += x * w0.x; acc[1] += x * w0.y; acc[2] += x * w0.z; acc[3] += x * w0.w; acc[4] += x * w1.x; acc[5] += x * w1.y; acc[6] += x * w1.z; acc[7] += x * w1.w; } }
#pragma unroll
            for (int h = 0; h < 8; ++h) acc[h] = wave_sum(acc[h], F.lane) + bb[h];
            if (MODE == 0) {
                float mine = acc[0];
#pragma unroll
                for (int h = 1; h < 8; ++h) mine = (F.lane == h) ? acc[h] : mine;
                if (F.lane < 8) logf[(size_t)r * 8 + F.lane] = log_sigmoid(mine);
            } else {
                int i1 = 0; float l1 = acc[0];
#pragma unroll
                for (int h = 1; h < 8; ++h) if (acc[h] > l1) { l1 = acc[h]; i1 = h; }
                int i2 = -1; float l2 = -3.0e38f;
#pragma unroll
                for (int h = 0; h < 8; ++h) if (h != i1 && acc[h] > l2) { l2 = acc[h]; i2 = h; }
                const float w1 = 1.0f / (1.0f + __builtin_amdgcn_exp2f(1.4426950408889634f * (l2 - l1))), w2 = 1.0f - w1;
                if (F.lane == 0) { tokE[2 * r] = i1; tokE[2 * r + 1] = i2; tokW[2 * r] = w1; tokW[2 * r + 1] = w2; }
                if (F.lane < 16) mycnt += ((F.lane < 8 ? i1 : i2) == (F.lane & 7)) ? 1 : 0;
            }
        }
    }
    if (MODE == 2) {
        if (F.lane < 16 && mycnt) __hip_atomic_fetch_add((unsigned*)a->ws + CW_CNT + F.lane, (unsigned)mycnt, __ATOMIC_RELAXED, __HIP_MEMORY_SCOPE_AGENT);
        int* rt = (int*)(a->ws + WS_ROWTOK);
        for (int i = (F.vcu * NWAVES * 64) + F.tid; i < 2 * RMAX; i += F.G * NWAVES * 64) rt[i] = -1;
    }
}
__device__ __forceinline__ void phase_conv(const Frame& F, ArgsP a, const float* convw  , int layer) {
    if (F.vcu < BATCH * NH) {
        const int b = F.vcu >> 3, h = F.vcu & 7; const float* lf = (const float*)(a->ws + WS_LOGF) + ((size_t)b * SEQ) * 8 + h; float* cb = (float*)(a->ws + WS_CB) + (size_t)F.vcu * SEQ;
        LAS float* wt = (LAS float*)F.lds;
        float v[32]; float run = 0.f;
#pragma unroll
        for (int i = 0; i < 32; ++i) { run += lf[(size_t)(F.tid * 32 + i) * 8]; v[i] = run; }
        float inc = run;
#pragma unroll
        for (int o = 1; o < 64; o <<= 1) { const float t = __int_as_float(__builtin_amdgcn_ds_bpermute(((F.lane - o) & 63) << 2, __float_as_int(inc))); if (F.lane >= o) inc += t; }
        if (F.lane == 63) wt[F.wave] = inc;
        __syncthreads();
        float base = inc - run;
        for (int w = 0; w < F.wave; ++w) base += wt[w];
#pragma unroll
        for (int i = 0; i < 32; ++i) cb[F.tid * 32 + i] = base + v[i];
        __syncthreads();
    }
    bf16* Bz = (bf16*)(a->ws + WS_P6); const bf16* Cb = Bz + (size_t)MTOK * 1024; const bf16* Ub = Bz + (size_t)2 * MTOK * 1024;
    const int gw = F.vcu * NWAVES + F.wave, NGW = F.G * NWAVES;
    { const bf16* Qb = Bz + (size_t)3 * MTOK * 1024; const bf16* Kb = Bz + (size_t)4 * MTOK * 1024; const int RPW = MTOK / NGW, r0 = gw * RPW; float qm = 0.f, km = 0.f;
      for (int r = r0; r < r0 + RPW; ++r) {
          const GAS v4u* qp = (const GAS v4u*)(Qb + (size_t)r * 1024) + 2 * F.lane; const GAS v4u* kp = (const GAS v4u*)(Kb + (size_t)r * 1024) + 2 * F.lane;
          const v4u q0 = qp[0], q1 = qp[1], k0 = kp[0], k1 = kp[1];
          const unsigned qq[8] = {q0.x, q0.y, q0.z, q0.w, q1.x, q1.y, q1.z, q1.w}, kk[8] = {k0.x, k0.y, k0.z, k0.w, k1.x, k1.y, k1.z, k1.w}; float sq = 0.f, sk = 0.f;
#pragma unroll
          for (int i = 0; i < 8; ++i) { const float a0 = pg8::bf_lo(qq[i]), a1 = pg8::bf_hi(qq[i]), b0 = pg8::bf_lo(kk[i]), b1 = pg8::bf_hi(kk[i]); sq += a0 * a0 + a1 * a1; sk += b0 * b0 + b1 * b1; }
#pragma unroll
          for (int o = 1; o < 8; o <<= 1) { sq += __int_as_float(__builtin_amdgcn_ds_bpermute((F.lane ^ o) << 2, __float_as_int(sq))); sk += __int_as_float(__builtin_amdgcn_ds_bpermute((F.lane ^ o) << 2, __float_as_int(sk))); }
          qm = fmaxf(qm, sq); km = fmaxf(km, sk); }
      if ((F.lane & 7) == 0) { unsigned* nm = (unsigned*)a->ws + CW_NMAX + layer * 32 + (r0 / SEQ) * 8 + (F.lane >> 3);
          __hip_atomic_fetch_max(nm, __float_as_uint(qm), __ATOMIC_RELAXED, __HIP_MEMORY_SCOPE_AGENT); __hip_atomic_fetch_max(nm + 16, __float_as_uint(km), __ATOMIC_RELAXED, __HIP_MEMORY_SCOPE_AGENT); } }
    for (int it = gw; it < (MTOK / 32) * 2; it += NGW) {
        const int hf = it & 1, t0 = (it >> 1) * 32, c0 = hf * 512 + F.lane * 8;
        float w0[8], w1[8], w2[8];
#pragma unroll
        for (int i = 0; i < 8; ++i) { w0[i] = convw[c0 + i]; w1[i] = convw[1024 + c0 + i]; w2[i] = convw[2048 + c0 + i]; }
        float p2[8], p1[8];
        const bool first = (t0 % SEQ) == 0;
        { v4u cw = {0u, 0u, 0u, 0u}, uw = cw, cw1 = cw, uw1 = cw;
          if (!first) { cw = *(const GAS v4u*)(Cb + (size_t)(t0 - 2) * 1024 + c0); uw = *(const GAS v4u*)(Ub + (size_t)(t0 - 2) * 1024 + c0);
                        cw1 = *(const GAS v4u*)(Cb + (size_t)(t0 - 1) * 1024 + c0); uw1 = *(const GAS v4u*)(Ub + (size_t)(t0 - 1) * 1024 + c0); }
          const unsigned cc[4] = {cw.x, cw.y, cw.z, cw.w}, uu[4] = {uw.x, uw.y, uw.z, uw.w}, cc1[4] = {cw1.x, cw1.y, cw1.z, cw1.w}, uu1[4] = {uw1.x, uw1.y, uw1.z, uw1.w};
#pragma unroll
          for (int q = 0; q < 4; ++q) { p2[2 * q] = pg8::bf_lo(cc[q]) * pg8::bf_lo(uu[q]); p2[2 * q + 1] = pg8::bf_hi(cc[q]) * pg8::bf_hi(uu[q]);
                                        p1[2 * q] = pg8::bf_lo(cc1[q]) * pg8::bf_lo(uu1[q]); p1[2 * q + 1] = pg8::bf_hi(cc1[q]) * pg8::bf_hi(uu1[q]); } }
#pragma unroll 4
        for (int i = 0; i < 32; ++i) { const size_t o = (size_t)(t0 + i) * 1024 + c0;
            const v4u cw = *(const GAS v4u*)(Cb + o), uw = *(const GAS v4u*)(Ub + o), bw = *(const GAS v4u*)(Bz + o);
            const unsigned cc[4] = {cw.x, cw.y, cw.z, cw.w}, uu[4] = {uw.x, uw.y, uw.z, uw.w}, bq[4] = {bw.x, bw.y, bw.z, bw.w}; float cur[8], z[8];
#pragma unroll
            for (int q = 0; q < 4; ++q) { cur[2 * q] = pg8::bf_lo(cc[q]) * pg8::bf_lo(uu[q]); cur[2 * q + 1] = pg8::bf_hi(cc[q]) * pg8::bf_hi(uu[q]); }
#pragma unroll
            for (int q = 0; q < 4; ++q) { z[2 * q] = pg8::bf_lo(bq[q]) * (w0[2 * q] * p2[2 * q] + w1[2 * q] * p1[2 * q] + w2[2 * q] * cur[2 * q]);
                                          z[2 * q + 1] = pg8::bf_hi(bq[q]) * (w0[2 * q + 1] * p2[2 * q + 1] + w1[2 * q + 1] * p1[2 * q + 1] + w2[2 * q + 1] * cur[2 * q + 1]); }
            v4u ow; ow.x = pk2(z[0], z[1]); ow.y = pk2(z[2], z[3]); ow.z = pk2(z[4], z[5]); ow.w = pk2(z[6], z[7]);
            *(GAS v4u*)(Bz + o) = ow;
#pragma unroll
            for (int q = 0; q < 8; ++q) { p2[q] = p1[q]; p1[q] = cur[q]; } }
    }
}
__device__ __forceinline__ fox::BlockRef<fox::bf16, fox::bf16> fox_ref(ArgsP a, int bh, int qb, int jlo) {
    fox::bf16* P6 = (fox::bf16*)(a->ws + WS_P6); const int b = bh >> 3, h = bh & 7; const size_t base = (size_t)b * SEQ * 1024 + h * 128;
    fox::BlockRef<fox::bf16, fox::bf16> r;
    r.Q = P6 + (size_t)3 * MTOK * 1024 + base + (size_t)qb * 256 * 1024; r.O = (fox::bf16*)r.Q;
    r.K = P6 + (size_t)4 * MTOK * 1024 + base; r.V = P6 + (size_t)5 * MTOK * 1024 + base;
    r.cb = (const float*)(a->ws + WS_CB) + (size_t)bh * SEQ; r.P0 = qb * 256; r.cref = r.cb[r.P0]; r.jlo = jlo;
    return r;
}
__device__ __forceinline__ void phase_attn(const Frame& F, ArgsP a, char* lds, int layer) {
    constexpr int NQB = SEQ / 256, NX = NQB / 2, TOTAL = BATCH * NH * NX;
    LAS int* jl = (LAS int*)(F.lds + JLO_OFF);
    for (int k = 0; k < 4; ++k) {
        const int Lk = F.vcu + (k >> 1) * F.G; int jlo = 0;
        if (Lk < TOTAL) { const int bh = Lk / NX, x = Lk % NX, qb = (k & 1) ? NQB - 1 - x : x, P0 = qb * 256, nt0 = P0 / 64;
            const float* cb = (const float*)(a->ws + WS_CB) + (size_t)bh * SEQ; const unsigned* nm = (const unsigned*)a->ws + CW_NMAX + layer * 32;
            const float U = fox::SCALE * sqrtf(__uint_as_float(nm[bh]) * __uint_as_float(nm[16 + bh])) * 1.001f, thr = 2.f * U + PRUNE_T, cref = cb[P0];
            bool keep = false; if (F.tid < nt0) keep = (cref - cb[64 * F.tid + 63]) > -thr;
            const unsigned long long m = __ballot(keep); const int first = m ? F.wave * 64 + (int)__builtin_ctzll(m) : (1 << 20);
            if (F.lane == 0) jl[4 + F.wave] = first;
            __syncthreads();
            jlo = nt0;
#pragma unroll
            for (int w = 0; w < 8; ++w) jlo = min(jlo, jl[4 + w]);
            __syncthreads(); }
        if (F.tid == 0) jl[k] = jlo;
    }
    __syncthreads();
    int L = F.vcu; if (L >= TOTAL) return;
    int pass = 0, it = 0;
    fox::BlockRef<fox::bf16, fox::bf16> cur = fox_ref(a, L / NX, L % NX, jl[0]);
    fox::Seam<fox::bf16> S;
    fox::causal_swa_prime<fox::bf16, fox::bf16>(cur, SEQ, lds, S, F.wave);
    for (;;) {
        const bool more_pass = pass == 0, more_item = L + F.G < TOTAL, last = !more_pass && !more_item;
        int passn = pass + 1, Ln = L, itn = it;
        if (!more_pass) { passn = 0; Ln = more_item ? L + F.G : L; itn = more_item ? it + 1 : it; }
        const int xn = Ln % NX;
        const fox::BlockRef<fox::bf16, fox::bf16> nxt = last ? cur : fox_ref(a, Ln / NX, passn ? NQB - 1 - xn : xn, jl[(2 * itn + passn) & 3]);
        fox::causal_swa_block<fox::bf16, fox::bf16>(cur, nxt, SEQ, SEQ, lds, S, F.wave);
        if (last) break;
        cur = nxt; pass = passn; L = Ln; it = itn;
    }
}
struct MoeLayout { int base[8]; int ntiles; };
__device__ __forceinline__ void moe_layout(ArgsP a, int rank, MoeLayout& ml) {
    const unsigned* cnt = (const unsigned*)a->ws + CW_CNT + rank * 8; int run = 0;
#pragma unroll
    for (int e = 0; e < 8; ++e) { ml.base[e] = run; run += ((int)cnt[e] + 255) & ~255; }
    ml.ntiles = run >> 8;
}
__device__ __forceinline__ void moe_tile_table(const Frame& F, ArgsP a, int rank, int& ntiles) {
    MoeLayout ml; moe_layout(a, rank, ml); ntiles = ml.ntiles;
    LAS int* te = (LAS int*)(F.lds + TILE_E_OFF);
    for (int t = F.tid; t < 160; t += NWAVES * 64) { int e = 0;
#pragma unroll
        for (int q = 1; q < 8; ++q) e += (t * 256 >= ml.base[q]) ? 1 : 0;
        te[t] = e; }
    __syncthreads();
}
__device__ __forceinline__ void gather_row(const bf16* src, unsigned char* dst, int lane) {
    const GAS v4u* s = (const GAS v4u*)src + 2 * lane; GAS v4u* d = (GAS v4u*)dst + lane;
    const v4u a0 = s[0], a1 = s[1], b0 = s[128], b1 = s[129];
#define G8(p, q) pg8::pk4_fp8(pg8::bf_lo(p) * pg8::F8_XS, pg8::bf_hi(p) * pg8::F8_XS, pg8::bf_lo(q) * pg8::F8_XS, pg8::bf_hi(q) * pg8::F8_XS)
    v4u o0, o1; o0.x = G8(a0.x, a0.y); o0.y = G8(a0.z, a0.w); o0.z = G8(a1.x, a1.y); o0.w = G8(a1.z, a1.w);
    o1.x = G8(b0.x, b0.y); o1.y = G8(b0.z, b0.w); o1.z = G8(b1.x, b1.y); o1.w = G8(b1.z, b1.w);
#undef G8
    d[0] = o0; d[64] = o1;
}
__device__ __forceinline__ void phase_route(const Frame& F, ArgsP a) {
    MoeLayout ml0, ml1; moe_layout(a, 0, ml0); moe_layout(a, 1, ml1);
    const int* tokE = (const int*)(a->ws + WS_TOKE); const float* tokW = (const float*)(a->ws + WS_TOKW);
    int* rowtok = (int*)(a->ws + WS_ROWTOK); float* roww = (float*)(a->ws + WS_ROWW); unsigned* cur = (unsigned*)a->ws + CW_CUR;
    const bf16* A2 = (const bf16*)(a->ws + WS_A); unsigned char* XG = (unsigned char*)(a->ws + WS_XG);
    const int gw = F.vcu * NWAVES + F.wave, NGW = F.G * NWAVES;
    for (int t0 = gw * 16; t0 < MTOK; t0 += NGW * 16) {
        const bool act = F.lane < 16; const int t = t0 + (F.lane & 15);
        int pos0 = 0;
#pragma unroll
        for (int rank = 0; rank < 2; ++rank) {
            const int e = act ? tokE[2 * t + rank] : -1; const float w = act ? tokW[2 * t + rank] : 0.f; int pos = -1;
#pragma unroll
            for (int q = 0; q < 8; ++q) { const unsigned long long m = __ballot(e == q);
                if (m) { unsigned b0 = 0; if (F.lane == 0) b0 = __hip_atomic_fetch_add(cur + rank * 8 + q, (unsigned)__popcll(m), __ATOMIC_RELAXED, __HIP_MEMORY_SCOPE_AGENT);
                    b0 = __builtin_amdgcn_readfirstlane(b0);
                    if (e == q) pos = (rank ? ml1.base[q] : ml0.base[q]) + (int)b0 + __popcll(m & ((1ull << F.lane) - 1ull)); } }
            if (act) { rowtok[rank * RMAX + pos] = t; roww[rank * RMAX + pos] = w; }
            if (rank == 0) pos0 = pos;
        }
        for (int i = 0; i < 16; ++i) { const int p = __builtin_amdgcn_readlane(pos0, i); gather_row(A2 + (size_t)(t0 + i) * DM, XG + (size_t)p * DM, F.lane); }
    }
}
__device__ __forceinline__ void phase_gather(const Frame& F, ArgsP a, int rank) {
    MoeLayout ml; moe_layout(a, rank, ml);
    const int* rowtok = (const int*)(a->ws + WS_ROWTOK) + rank * RMAX; const bf16* A2 = (const bf16*)(a->ws + WS_A); unsigned char* XG = (unsigned char*)(a->ws + WS_XG);
    const int gw = F.vcu * NWAVES + F.wave, NGW = F.G * NWAVES, nrows = ml.ntiles * 256;
    for (int p = gw; p < nrows; p += NGW) { const int t = rowtok[p]; if (t >= 0) gather_row(A2 + (size_t)t * DM, XG + (size_t)p * DM, F.lane); }
}

__global__ void __launch_bounds__(NWAVES * 64, 2) fwd(Args args) {
    extern __shared__ __attribute__((aligned(16))) unsigned char lds_raw[];
    { const int t0 = threadIdx.x; for (int u = t0; u < (LDS_BYTES - LDSCTL_OFF) / 4; u += NWAVES * 64) ((LAS unsigned*)((LAS unsigned char*)lds_raw + LDSCTL_OFF))[u] = 0u; }
    __syncthreads();
    (void)xcd_barrier_post((unsigned*)args.ws + CW_BAR, (volatile LAS unsigned*)((LAS unsigned char*)lds_raw + MISC_OFF) + 8);
    const int lo = args.ph_lo, hi = args.ph_hi; int ph = 0;
    const int wave0 = __builtin_amdgcn_readfirstlane((int)threadIdx.x >> 6);
#define FORCE_SEAM() do { XcdBarrier b3; b3.bar = (unsigned*)args.ws + CW_BAR; b3.x = xb_xcc_id(); b3.st = (volatile LAS unsigned*)((LAS unsigned char*)lds_raw + MISC_OFF) + 8; xcd_barrier(b3); } while (0)
#define PH_ON (ph >= lo && ph < hi)
#define PH_SEAM() do { if (ph + 1 < hi) { XcdBarrier b2; b2.bar = (unsigned*)ws + CW_BAR; b2.x = xb_xcc_id(); b2.st = (volatile LAS unsigned*)((LAS unsigned char*)lds_raw + MISC_OFF) + 8; xcd_barrier(b2); } } while (0)
#define PH_FRAME() Frame F; F.lds = (LAS unsigned char*)lds_raw; F.tid = pg8::opaque_tid(wave0); F.lane = F.tid & 63; F.wave = __builtin_amdgcn_readfirstlane(F.tid >> 6); \
    F.G = gridDim.x; { const int bx = blockIdx.x; F.vcu = (F.G % 8 == 0) ? (bx % 8) * (F.G / 8) + bx / 8 : bx; } \
    ArgsP A = (ArgsP)__builtin_amdgcn_kernarg_segment_ptr(); asm volatile("" : "+s"(A)); unsigned char* ws = A->ws; float* const out = A->out; (void)out; \
    bf16* const A_ = (bf16*)(ws + WS_A); bf16* const P6_ = (bf16*)(ws + WS_P6); bf16* const G_ = (bf16*)(ws + WS_G); (void)A_; (void)P6_; (void)G_

    if (PH_ON) {  PH_FRAME(); phase_convert(F, A);  PH_SEAM(); } ++ph;

    for (int layer = 0; layer < 2; ++layer) {

        if (PH_ON) {  PH_FRAME(); phase_norm<0>(F, A, layer == 0 ? A->in[I_X] : (const float*)out, A->in[I_MIXN] + layer * DM, A_, nullptr, A->in[I_WIN] + (size_t)layer * DM * PTOT + 6144, PTOT, A->in[I_BF] + layer * 8);  PH_SEAM(); } ++ph;
        if (PH_ON) {  PH_FRAME(); pg8::Gemm g{A_, (const bf16*)(ws + WS_WIN) + (size_t)layer * NPROJ * DM, MTOK, NPROJ, DM}; pg8::StaticOrder S; S.init(MTOK, NPROJ, F.G, (int)blockIdx.x);
            pg8::EpiInProj E{P6_, G_, MTOK};
            pg8::gemm_phase<pg8::EpiInProj, pg8::StaticOrder, true, true>(F.lds, g, S, E, F.tid);  PH_SEAM(); } ++ph;
        if (PH_ON) { PH_FRAME(); phase_conv(F, A, A->in[I_CONVW] + layer * 3 * DCONV, layer); PH_SEAM(); } ++ph;
        if (PH_ON) { { PH_FRAME(); phase_attn(F, A, (char*)lds_raw, layer); }
             PH_FRAME(); pg8::Gemm g{P6_, (const bf16*)(ws + WS_WCO) + (size_t)layer * DM * 1024, MTOK, DM, 1024}; pg8::StaticOrder S; S.init(MTOK, DM, F.G, (int)blockIdx.x);
            pg8::EpiMerge<0> E{G_, A_};
            pg8::gemm_phase<pg8::EpiMerge<0>, pg8::StaticOrder, true, true>(F.lds, g, S, E, F.tid);  PH_SEAM(); } ++ph;
        if (PH_ON) { PH_FRAME(); pg8::Gemm g{P6_ + (size_t)3 * MTOK * 1024, (const bf16*)(ws + WS_WAO) + (size_t)layer * DM * 1024, MTOK, DM, 1024}; pg8::StaticOrder S; S.init(MTOK, DM, F.G, (int)blockIdx.x);
            pg8::EpiMerge<1> E{G_ + 2048, A_};
            pg8::gemm_phase<pg8::EpiMerge<1>, pg8::StaticOrder, true, true>(F.lds, g, S, E, F.tid); PH_SEAM(); } ++ph;
        if (PH_ON) {  PH_FRAME(); pg8::Gemm g{A_, (const bf16*)(ws + WS_WO) + (size_t)layer * DM * DM, MTOK, DM, DM}; pg8::StaticOrder S; S.init(MTOK, DM, F.G, (int)blockIdx.x);
            pg8::EpiResid E{layer == 0 ? A->in[I_X] : (const float*)out, out};
            pg8::gemm_phase<pg8::EpiResid, pg8::StaticOrder, true, true>(F.lds, g, S, E, F.tid);  PH_SEAM(); } ++ph;
        if (layer == 0) {
            if (PH_ON) {  PH_FRAME(); phase_norm<1>(F, A, out, A->in[I_FFNN], A_, nullptr, nullptr, 0, nullptr);  PH_SEAM(); } ++ph;
            if (PH_ON) {  PH_FRAME(); pg8::Gemm g{A_, (const bf16*)(ws + WS_WGU), MTOK, 2 * DFF, DM}; pg8::StaticOrder S; S.init(MTOK, 2 * DFF, F.G, (int)blockIdx.x);
                pg8::EpiSwiGLU E{(bf16*)(ws + WS_HID), DFF};
                pg8::gemm_phase<pg8::EpiSwiGLU, pg8::StaticOrder, true, true>(F.lds, g, S, E, F.tid);  PH_SEAM(); } ++ph;
            if (PH_ON) { PH_FRAME(); pg8::Gemm g{(const bf16*)(ws + WS_HID), (const bf16*)(ws + WS_WDD), MTOK, DM, DFF}; pg8::StaticOrder S; S.init(MTOK, DM, F.G, (int)blockIdx.x);
                pg8::EpiResid E{out, out};
                pg8::gemm_phase<pg8::EpiResid, pg8::StaticOrder, true, true>(F.lds, g, S, E, F.tid); PH_SEAM(); } ++ph;
        } else {
            if (PH_ON) { PH_FRAME(); phase_norm<2>(F, A, out, A->in[I_FFNN] + DM, A_, nullptr, A->in[I_RW], 8, A->in[I_RB]); PH_SEAM(); } ++ph;
            if (PH_ON) { PH_FRAME(); phase_route(F, A); PH_SEAM(); } ++ph;
            for (int rank = 0; rank < 2; ++rank) {
                if (rank == 1) { if (PH_ON) {  PH_FRAME(); phase_gather(F, A, 1);  PH_SEAM(); } ++ph; }
                if (PH_ON) {  PH_FRAME(); int nt; moe_tile_table(F, A, rank, nt);
                    pg8::Gemm g{(const bf16*)(ws + WS_XG), (const bf16*)(ws + WS_MWGU), nt * 256, 2 * DFFE, DM}; pg8::MoeOrder S; S.init(nt * 256, 2 * DFFE, F.G, (int)blockIdx.x);
                    S.tile_e = (const LAS int*)(F.lds + TILE_E_OFF); S.estride = (size_t)2 * DFFE * DM;
                    pg8::EpiSwiGLU8 E{(unsigned char*)(ws + WS_HID), DFFE};
                    pg8::gemm_phase<pg8::EpiSwiGLU8, pg8::MoeOrder, true, true, true>(F.lds, g, S, E, F.tid);  PH_SEAM(); } ++ph;
                if (PH_ON) { PH_FRAME(); int nt; moe_tile_table(F, A, rank, nt);
                    pg8::Gemm g{(const bf16*)(ws + WS_HID), (const bf16*)(ws + WS_MWD), nt * 256, DM, DFFE}; pg8::MoeOrder S; S.init(nt * 256, DM, F.G, (int)blockIdx.x);
                    S.tile_e = (const LAS int*)(F.lds + TILE_E_OFF); S.estride = (size_t)DM * DFFE;
                    pg8::EpiMoeDown E{(const int*)(ws + WS_ROWTOK) + rank * RMAX, (const float*)(ws + WS_ROWW) + rank * RMAX, out, 1.0f / (pg8::F8_HS * pg8::F8_WS)};
                    pg8::gemm_phase<pg8::EpiMoeDown, pg8::MoeOrder, true, true, true>(F.lds, g, S, E, F.tid); PH_SEAM(); } ++ph;
            }
        }
    }
    if (PH_ON) { PH_FRAME(); phase_norm<3>(F, A, out, A->in[I_FN], nullptr, out, nullptr, 0, nullptr); } ++ph;
#undef PH_ON
#undef PH_SEAM
#undef PH_FRAME
}
constexpr int N_PHASES = 1 + 6 + 3 + 6 + 2 + 1 + 2 * 2 + 1;

extern "C" void kernel_launch(void* const* d_in, const int* in_sizes, int n_in, void* d_out, int out_size, void* d_ws, size_t ws_size, hipStream_t stream) {
    static int grid = 0;
    if (grid == 0) {
        if (n_in != N_IN || in_sizes[0] != MTOK * DM || out_size != MTOK * DM || ws_size < WS_END) { fprintf(stderr, "kernel_launch: shape/workspace mismatch (n_in %d, ws %zu, need %zu); nothing launched\n", n_in, ws_size, (size_t)WS_END); grid = -1; return; }
        int dev = 0, cus = 0, per_cu = 0;
        if (hipGetDevice(&dev) != hipSuccess || hipDeviceGetAttribute(&cus, hipDeviceAttributeMultiprocessorCount, dev) != hipSuccess) { grid = -1; return; }
        if (hipFuncSetAttribute((const void*)fwd, hipFuncAttributeMaxDynamicSharedMemorySize, LDS_BYTES) != hipSuccess) { fprintf(stderr, "kernel_launch: hipFuncSetAttribute failed\n"); grid = -1; return; }
        if (hipOccupancyMaxActiveBlocksPerMultiprocessor(&per_cu, (const void*)fwd, NWAVES * 64, LDS_BYTES) != hipSuccess || per_cu < 1) { fprintf(stderr, "kernel_launch: occupancy query says %d\n", per_cu); grid = -1; (void)hipGetLastError(); return; }
        grid = cus;
        if (MTOK % (grid * NWAVES) != 0) { fprintf(stderr, "kernel_launch: grid %d does not divide the token rows\n", grid); grid = -1; return; }
    }
    if (grid < 0) return;
    if (hipMemsetAsync((char*)d_ws + WS_CTL, 0, CTL_ZERO_BYTES, stream) != hipSuccess) return;
    Args ka; memset(&ka, 0, sizeof(ka));
    for (int i = 0; i < N_IN; ++i) ka.in[i] = (const float*)d_in[i];
    ka.out = (float*)d_out; ka.ws = (unsigned char*)d_ws;
#if MK_PER_PHASE
    for (int p = 0; p < N_PHASES; ++p) { ka.ph_lo = p; ka.ph_hi = p + 1; hipLaunchKernelGGL(fwd, dim3(grid), dim3(NWAVES * 64), LDS_BYTES, stream, ka); }
#else
    ka.ph_lo = 0; ka.ph_hi = N_PHASES; hipLaunchKernelGGL(fwd, dim3(grid), dim3(NWAVES * 64), LDS_BYTES, stream, ka);
#endif
}
```

```cpp
#include <hip/hip_runtime.h>
#include <cstdio>
#include <cstdint>
#include <cstring>
namespace pg8 {
#define PG8_LAS __attribute__((address_space(3)))
typedef unsigned short bf16_t;
typedef short bf16x8 __attribute__((ext_vector_type(8)));
typedef float f32x4 __attribute__((ext_vector_type(4)));
typedef unsigned u32x4 __attribute__((ext_vector_type(4)));
constexpr int BM = 256, BK = 64, HALF = 128, HTB = HALF * BK * 2  , STAGE_BYTES = 8 * HTB, NXCD = 8, WGM = 8;

__host__ __device__ __forceinline__ int lds_byte(int r, int c) { const int st = (r >> 4) * 2 + (c >> 5), rr = r & 15, cc = c & 31, ob = rr * 64 + cc * 2; return st * 1024 + (ob ^ (((ob >> 9) & 1) << 5)); }
__host__ __device__ __forceinline__ void stage_rc(int b, int& R, int& C) { const int st = b / 1024, sb = b % 1024, swz = sb ^ (((sb >> 9) & 1) << 5); R = (st >> 1) * 16 + swz / 64; C = (st & 1) * 32 + (swz % 64) / 2; }
__host__ __device__ __forceinline__ int perm32(int rho) { const int n = rho >> 4, i = rho & 15; return 8 * (i >> 2) + 4 * n + (i & 3); }

__device__ __forceinline__ int opaque_tid(int wave_sgpr) { int l; asm volatile("v_mbcnt_lo_u32_b32 %0, -1, 0\n\tv_mbcnt_hi_u32_b32 %0, -1, %0" : "=v"(l)); return (wave_sgpr << 6) | l; }
typedef int i32x8 __attribute__((ext_vector_type(8)));
typedef int i32x4 __attribute__((ext_vector_type(4)));
__device__ __forceinline__ i32x8 cat8(bf16x8 lo, bf16x8 hi) { const i32x4 a = __builtin_bit_cast(i32x4, lo), b = __builtin_bit_cast(i32x4, hi); return __builtin_shufflevector(a, b, 0, 1, 2, 3, 4, 5, 6, 7); }
struct Unit { int pm, pn; };
struct Gemm { const bf16_t* A; const bf16_t* Bt; int M, N, K; };

struct StaticOrder {
    int nM, nN, nwg, G, c;
    __host__ __device__ void init(int M, int N, int G_, int c_) { nM = M / BM; nN = N / BM; nwg = nM * nN; G = G_; c = c_; }
    __host__ __device__ bool next(int i, Unit& u) const {
        const long L = (long)i * G + c; if (L >= nwg) return false;
        int wgid = (int)L; { const int q = nwg / NXCD, r = nwg % NXCD, xcd = wgid % NXCD, off = wgid / NXCD; wgid = (xcd < r ? xcd * (q + 1) : r * (q + 1) + (xcd - r) * q) + off; }
        const int nig = WGM * nN, gid = wgid / nig, fm = gid * WGM, gsz = (nM - fm) < WGM ? (nM - fm) : WGM;
        u.pm = fm + ((wgid % nig) % gsz); u.pn = (wgid % nig) / gsz; return true;
    }
    __device__ __forceinline__ void a_ready(const Unit&) const {}
    __device__ __forceinline__ void done(const Unit&) const {}
    __device__ __forceinline__ const char* bbase(const Gemm& g, const Unit&) const { return (const char*)g.Bt; }
};
__device__ __forceinline__ unsigned cvt_pk_bf16(float lo, float hi) { unsigned r; asm volatile("v_cvt_pk_bf16_f32 %0, %1, %2" : "=v"(r) : "v"(lo), "v"(hi)); return r; }
typedef float f32x2 __attribute__((ext_vector_type(2)));
__device__ __forceinline__ float sigm(float x) { return __builtin_amdgcn_rcpf(1.0f + __builtin_amdgcn_exp2f(-1.4426950408889634f * x)); }
__device__ __forceinline__ float bf_lo(unsigned w) { return __uint_as_float(w << 16); }
__device__ __forceinline__ float bf_hi(unsigned w) { return __uint_as_float(w & 0xffff0000u); }

struct EpiInProj {
    static constexpr bool PERM = true, AFTER_DRAIN = false;
    bf16_t* P6; bf16_t* Gt; int M;
    __device__ __forceinline__ void operator()(const f32x4 (&acc)[2][2][4][2], const Unit& u, int wr, int wc, int fr, int fq) const {
        const int row0 = u.pm * BM + wr * 64 + fr; const int colt = u.pn * BM; const int t = colt >> 10; const bool gate = t >= 6;
        bf16_t* base = gate ? Gt + (colt - 6144) : P6 + (size_t)t * M * 1024 + (colt & 1023);
        const int ldc = gate ? 4096 : 1024; const int col0 = wc * 32 + 8 * fq;
#pragma unroll
        for (int ai = 0; ai < 2; ++ai)
#pragma unroll
            for (int m = 0; m < 4; ++m) { bf16_t* rowp = base + (size_t)(row0 + ai * HALF + m * 16) * ldc + col0;
#pragma unroll
                for (int bj = 0; bj < 2; ++bj) { f32x4 v0 = acc[ai][bj][m][0], v1 = acc[ai][bj][m][1];
                    if (gate) {
#pragma unroll
                        for (int j = 0; j < 4; ++j) { v0[j] = sigm(v0[j]); v1[j] = sigm(v1[j]); } }
                    u32x4 w; w.x = cvt_pk_bf16(v0[0], v0[1]); w.y = cvt_pk_bf16(v0[2], v0[3]); w.z = cvt_pk_bf16(v1[0], v1[1]); w.w = cvt_pk_bf16(v1[2], v1[3]);
                    *(u32x4*)(rowp + bj * HALF) = w; } }
    }
};
template <int MODE> struct EpiMerge {
    static constexpr bool PERM = true, AFTER_DRAIN = false;
    const bf16_t* Gt; bf16_t* Mb;
    __device__ __forceinline__ void operator()(const f32x4 (&acc)[2][2][4][2], const Unit& u, int wr, int wc, int fr, int fq) const {
        const int row0 = u.pm * BM + wr * 64 + fr; const int col0 = u.pn * BM + wc * 32 + 8 * fq;
#pragma unroll
        for (int ai = 0; ai < 2; ++ai)
#pragma unroll
            for (int m = 0; m < 4; ++m) { const size_t r = (size_t)(row0 + ai * HALF + m * 16); const bf16_t* gp = Gt + r * 4096 + col0; bf16_t* mp = Mb + r * 2048 + col0;
#pragma unroll
                for (int bj = 0; bj < 2; ++bj) { const u32x4 gw = *(const u32x4*)(gp + bj * HALF); const f32x4 a0 = acc[ai][bj][m][0], a1 = acc[ai][bj][m][1];
                    f32x4 v0, v1;
                    v0[0] = bf_lo(gw.x) * a0[0]; v0[1] = bf_hi(gw.x) * a0[1]; v0[2] = bf_lo(gw.y) * a0[2]; v0[3] = bf_hi(gw.y) * a0[3];
                    v1[0] = bf_lo(gw.z) * a1[0]; v1[1] = bf_hi(gw.z) * a1[1]; v1[2] = bf_lo(gw.w) * a1[2]; v1[3] = bf_hi(gw.w) * a1[3];
                    if (MODE == 1) { const u32x4 mw = *(const u32x4*)(mp + bj * HALF);
                        v0[0] += bf_lo(mw.x); v0[1] += bf_hi(mw.x); v0[2] += bf_lo(mw.y); v0[3] += bf_hi(mw.y);
                        v1[0] += bf_lo(mw.z); v1[1] += bf_hi(mw.z); v1[2] += bf_lo(mw.w); v1[3] += bf_hi(mw.w); }
                    u32x4 w; w.x = cvt_pk_bf16(v0[0], v0[1]); w.y = cvt_pk_bf16(v0[2], v0[3]); w.z = cvt_pk_bf16(v1[0], v1[1]); w.w = cvt_pk_bf16(v1[2], v1[3]);
                    *(u32x4*)(mp + bj * HALF) = w; } }
    }
};
struct EpiResid {
    static constexpr bool PERM = false, AFTER_DRAIN = false;
    const float* base; float* out;
    __device__ __forceinline__ void operator()(const f32x4 (&acc)[2][2][4][2], const Unit& u, int wr, int wc, int fr, int fq) const {
        const int row0 = u.pm * BM + wr * 64 + fr, col0 = u.pn * BM + wc * 32 + 4 * fq;
#pragma unroll
        for (int ai = 0; ai < 2; ++ai)
#pragma unroll
            for (int m = 0; m < 4; ++m) { const size_t off = (size_t)(row0 + ai * HALF + m * 16) * 2048 + col0;
#pragma unroll
                for (int bj = 0; bj < 2; ++bj)
#pragma unroll
                    for (int n = 0; n < 2; ++n) { const f32x4 bs = *(const f32x4*)(base + off + bj * HALF + n * 16); *(f32x4*)(out + off + bj * HALF + n * 16) = bs + acc[ai][bj][m][n]; }
                asm volatile("" ::: "memory"); }
    }
};
struct EpiSwiGLU {
    static constexpr bool PERM = true, AFTER_DRAIN = false;
    bf16_t* H; int ldh;
    __device__ __forceinline__ void operator()(const f32x4 (&acc)[2][2][4][2], const Unit& u, int wr, int wc, int fr, int fq) const {
        const int row0 = u.pm * BM + wr * 64 + fr; const int col0 = u.pn * HALF + wc * 32 + 8 * fq;
#pragma unroll
        for (int ai = 0; ai < 2; ++ai)
#pragma unroll
            for (int m = 0; m < 4; ++m) { bf16_t* rowp = H + (size_t)(row0 + ai * HALF + m * 16) * ldh + col0;
                const f32x4 g0 = acc[ai][0][m][0], g1 = acc[ai][0][m][1], u0 = acc[ai][1][m][0], u1 = acc[ai][1][m][1]; f32x4 v0, v1;
#pragma unroll
                for (int j = 0; j < 4; ++j) { v0[j] = g0[j] * sigm(g0[j]) * u0[j]; v1[j] = g1[j] * sigm(g1[j]) * u1[j]; }
                u32x4 w; w.x = cvt_pk_bf16(v0[0], v0[1]); w.y = cvt_pk_bf16(v0[2], v0[3]); w.z = cvt_pk_bf16(v1[0], v1[1]); w.w = cvt_pk_bf16(v1[2], v1[3]);
                *(u32x4*)rowp = w; }
    }
};
constexpr float F8_XS = 16.f, F8_WS = 256.f, F8_HS = 8.f;
__device__ __forceinline__ float clamp448(float x) { return __builtin_amdgcn_fmed3f(x, -448.f, 448.f); }
__device__ __forceinline__ unsigned pk4_fp8(float a, float b, float c, float d) { unsigned w = 0u; w = (unsigned)__builtin_amdgcn_cvt_pk_fp8_f32(clamp448(a), clamp448(b), (int)w, false); w = (unsigned)__builtin_amdgcn_cvt_pk_fp8_f32(clamp448(c), clamp448(d), (int)w, true); return w; }
struct EpiSwiGLU8 {
    static constexpr bool PERM = true, AFTER_DRAIN = false;
    unsigned char* H; int ldh;
    __device__ __forceinline__ void operator()(const f32x4 (&acc)[2][2][4][2], const Unit& u, int wr, int wc, int fr, int fq) const {
        const int row0 = u.pm * BM + wr * 64 + fr; const int col0 = u.pn * HALF + wc * 32 + 8 * fq; constexpr float INV = 1.0f / (F8_XS * F8_WS);
#pragma unroll
        for (int ai = 0; ai < 2; ++ai)
#pragma unroll
            for (int m = 0; m < 4; ++m) { unsigned char* rowp = H + (size_t)(row0 + ai * HALF + m * 16) * ldh + col0;
                const f32x4 g0 = acc[ai][0][m][0] * INV, g1 = acc[ai][0][m][1] * INV, u0 = acc[ai][1][m][0] * (INV * F8_HS), u1 = acc[ai][1][m][1] * (INV * F8_HS); f32x4 v0, v1;
#pragma unroll
                for (int j = 0; j < 4; ++j) { v0[j] = g0[j] * sigm(g0[j]) * u0[j]; v1[j] = g1[j] * sigm(g1[j]) * u1[j]; }
                uint2 w; w.x = pk4_fp8(v0[0], v0[1], v0[2], v0[3]); w.y = pk4_fp8(v1[0], v1[1], v1[2], v1[3]);
                *(uint2*)rowp = w; }
    }
};
struct EpiMoeDown {
    static constexpr bool PERM = false, AFTER_DRAIN = false;
    const int* row_tok; const float* row_w; float* h; float oscale;
    __device__ __forceinline__ void operator()(const f32x4 (&acc)[2][2][4][2], const Unit& u, int wr, int wc, int fr, int fq) const {
        const int rloc = u.pm * BM + wr * 64 + fr, col0 = u.pn * BM + wc * 32 + 4 * fq;
#pragma unroll
        for (int ai = 0; ai < 2; ++ai)
#pragma unroll
            for (int m = 0; m < 4; ++m) { const int r = rloc + ai * HALF + m * 16; const int tok = row_tok[r]; const float w = row_w[r] * oscale;
                if (tok >= 0) { float* p = h + (size_t)tok * 2048 + col0;
#pragma unroll
                    for (int bj = 0; bj < 2; ++bj)
#pragma unroll
                        for (int n = 0; n < 2; ++n) { const f32x4 bs = *(const f32x4*)(p + bj * HALF + n * 16); *(f32x4*)(p + bj * HALF + n * 16) = bs + w * acc[ai][bj][m][n]; } }
                asm volatile("" ::: "memory"); }
    }
};
struct MoeOrder : StaticOrder {
    const PG8_LAS int* tile_e; size_t estride;
    __device__ __forceinline__ const char* bbase(const Gemm& g, const Unit& u) const { return (const char*)g.Bt + (size_t)__builtin_amdgcn_readfirstlane(tile_e[u.pm]) * estride; }
};
template <class Epi, class Sched, bool ALIGN_EPI = false, bool SP2 = false, bool FP8 = false>
__device__ __forceinline__ void gemm_phase(PG8_LAS unsigned char* lds, const Gemm g, const Sched& S, const Epi& E, const int tid_in  ) {
    const int tid = tid_in, wid = __builtin_amdgcn_readfirstlane(tid >> 6), lane = tid & 63, wr = wid >> 2, wc = wid & 3, fr = lane & 15, fq = lane >> 4;
    const int K = FP8 ? g.K / 2 : g.K  , nt = K / BK;
    unsigned voffA[2], voffB[2];
#pragma unroll
    for (int i = 0; i < 2; ++i) { int R, C; stage_rc(tid * 16 + i * 8192, R, C); const int Rb = Epi::PERM ? ((R & ~31) + perm32(R & 31)) : R;
        const int Cb = FP8 ? 16 * (2 * ((C & 31) >> 3) + (C >> 5)) : C * 2;
        voffA[i] = (unsigned)(R * K) * 2u + (unsigned)Cb; voffB[i] = (unsigned)(Rb * K) * 2u + (unsigned)Cb; }
    const size_t kstep = (size_t)(BK * 2);
    const size_t hstep = (size_t)HALF * K * 2;
    const size_t tstep = 2 * hstep;
    const unsigned ldsw = (unsigned)wid * 1024u;
    const int aoff = lds_byte(wr * 64 + fr, fq * 8), boff = lds_byte(wc * 32 + fr, fq * 8);
#define PG8_SA(b, h) (((b) * 2 + (h)) * HTB)
#define PG8_SB(b, h) ((4 + (b) * 2 + (h)) * HTB)
#define PG8_STAGE(bufoff, gbase, voff) do { _Pragma("unroll") for (int _i = 0; _i < 2; ++_i) \
        __builtin_amdgcn_global_load_lds((const unsigned*)((const char*)(gbase) + (voff)[_i]), (PG8_LAS unsigned*)(lds + (bufoff) + ldsw + _i * 8192), 16, 0, 0); } while (0)
#define PG8_LDA(dst, b, h) do { _Pragma("unroll") for (int m = 0; m < 4; ++m) _Pragma("unroll") for (int k = 0; k < 2; ++k) dst[m][k] = *(const PG8_LAS bf16x8*)(lds + PG8_SA(b, h) + aoff + m * 2048 + k * 1024); } while (0)
#define PG8_LDB(dst, b, h) do { _Pragma("unroll") for (int n = 0; n < 2; ++n) _Pragma("unroll") for (int k = 0; k < 2; ++k) dst[n][k] = *(const PG8_LAS bf16x8*)(lds + PG8_SB(b, h) + boff + n * 2048 + k * 1024); } while (0)
#define PG8_MMA(ai, bj, At, Bt) do { __builtin_amdgcn_s_setprio(1); if constexpr (FP8) { _Pragma("unroll") for (int m = 0; m < 4; ++m) _Pragma("unroll") for (int n = 0; n < 2; ++n) \
        asm("v_mfma_f32_16x16x128_f8f6f4 %0, %1, %2, %0" : "+v"(acc[ai][bj][m][n]) : "v"(cat8(Bt[n][0], Bt[n][1])), "v"(cat8(At[m][0], At[m][1]))); }   \
      else { _Pragma("unroll") for (int m = 0; m < 4; ++m) _Pragma("unroll") for (int n = 0; n < 2; ++n) _Pragma("unroll") for (int k = 0; k < 2; ++k) \
        acc[ai][bj][m][n] = __builtin_amdgcn_mfma_f32_16x16x32_bf16(Bt[n][k], At[m][k], acc[ai][bj][m][n], 0, 0, 0); } __builtin_amdgcn_s_setprio(0); } while (0)
#define PG8_WAIT_V(n) asm volatile("s_waitcnt vmcnt(" #n ")" ::: "memory")
#define PG8_WAIT_L(n) asm volatile("s_waitcnt lgkmcnt(" #n ")" ::: "memory")
#define PG8_BAR __builtin_amdgcn_s_barrier()
#define PG8_SCHED __builtin_amdgcn_sched_barrier(0)
    Unit cur, nxt; int ui = 0;
    if (!S.next(0, cur)) return;
    f32x4 acc[2][2][4][2];
#pragma unroll
    for (int a = 0; a < 2; ++a)
#pragma unroll
        for (int b = 0; b < 2; ++b)
#pragma unroll
            for (int m = 0; m < 4; ++m)
#pragma unroll
                for (int n = 0; n < 2; ++n) acc[a][b][m][n] = (f32x4){0.f, 0.f, 0.f, 0.f};
    bf16x8 At[4][2], B0[2][2], B1[2][2];
    const char* cA = (const char*)g.A + (size_t)cur.pm * tstep; const char* cB = S.bbase(g, cur) + (size_t)cur.pn * tstep;
    S.a_ready(cur);
    if constexpr (SP2) {
        PG8_STAGE(PG8_SB(0, 0), cB, voffB); PG8_STAGE(PG8_SB(0, 1), cB + hstep, voffB); PG8_STAGE(PG8_SA(0, 0), cA, voffA); PG8_STAGE(PG8_SA(0, 1), cA + hstep, voffA);
        if (wr == 1) PG8_BAR;
        PG8_WAIT_V(2); PG8_BAR;
        PG8_STAGE(PG8_SB(1, 0), cB + kstep, voffB); PG8_STAGE(PG8_SA(1, 0), cA + kstep, voffA); PG8_STAGE(PG8_SB(1, 1), cB + hstep + kstep, voffB);
        PG8_WAIT_V(6); PG8_BAR;
    } else {
        PG8_STAGE(PG8_SB(0, 0), cB, voffB); PG8_STAGE(PG8_SA(0, 0), cA, voffA); PG8_STAGE(PG8_SB(0, 1), cB + hstep, voffB); PG8_STAGE(PG8_SA(0, 1), cA + hstep, voffA);
        if (wr == 1) PG8_BAR;
        PG8_WAIT_V(4); PG8_BAR;
        PG8_STAGE(PG8_SB(1, 0), cB + kstep, voffB); PG8_STAGE(PG8_SA(1, 0), cA + kstep, voffA); PG8_STAGE(PG8_SB(1, 1), cB + hstep + kstep, voffB);
        PG8_WAIT_V(6); PG8_BAR;
    }
    for (;;) {
        const bool has_next = S.next(ui + 1, nxt);
        const char* nA = has_next ? (const char*)g.A + (size_t)nxt.pm * tstep : cA; const char* nB = has_next ? S.bbase(g, nxt) + (size_t)nxt.pn * tstep : cB;
        for (int t = 0; t < nt; t += 2) {
            const bool last = (t == nt - 2);
            const char* a1 = cA + (size_t)(t + 1) * kstep;
            const char* a2 = last ? nA : cA + (size_t)(t + 2) * kstep; const char* b2 = last ? nB : cB + (size_t)(t + 2) * kstep;
            const char* a3 = a2 + kstep; const char* b3 = b2 + kstep;
            if (last && has_next) S.a_ready(nxt);
            if constexpr (SP2) {
            PG8_LDB(B0, 0, 0); PG8_LDB(B1, 0, 1); PG8_SCHED; PG8_LDA(At, 0, 0); PG8_STAGE(PG8_SA(1, 1), a1 + hstep, voffA);
            PG8_WAIT_V(8); PG8_WAIT_L(0); PG8_BAR; PG8_MMA(0, 0, At, B0); PG8_MMA(0, 1, At, B1); PG8_BAR; PG8_SCHED;
            PG8_LDA(At, 0, 1); PG8_STAGE(PG8_SB(0, 0), b2, voffB); PG8_STAGE(PG8_SB(0, 1), b2 + hstep, voffB); PG8_STAGE(PG8_SA(0, 0), a2, voffA);
            PG8_WAIT_V(8); PG8_WAIT_L(0); PG8_BAR; PG8_MMA(1, 0, At, B0); PG8_MMA(1, 1, At, B1); PG8_BAR; PG8_SCHED;
            PG8_LDB(B0, 1, 0); PG8_LDB(B1, 1, 1); PG8_SCHED; PG8_LDA(At, 1, 0); PG8_STAGE(PG8_SA(0, 1), a2 + hstep, voffA);
            PG8_WAIT_V(8); PG8_WAIT_L(0); PG8_BAR; PG8_MMA(0, 0, At, B0); PG8_MMA(0, 1, At, B1); PG8_BAR; PG8_SCHED;
            PG8_LDA(At, 1, 1); PG8_STAGE(PG8_SB(1, 0), b3, voffB); PG8_STAGE(PG8_SB(1, 1), b3 + hstep, voffB); PG8_STAGE(PG8_SA(1, 0), a3, voffA);
            PG8_WAIT_V(8); PG8_WAIT_L(0); PG8_BAR; PG8_MMA(1, 0, At, B0); PG8_MMA(1, 1, At, B1); PG8_BAR; PG8_SCHED;
            } else {
            PG8_LDB(B0, 0, 0); PG8_SCHED; PG8_LDA(At, 0, 0); PG8_STAGE(PG8_SA(1, 1), a1 + hstep, voffA);
            PG8_WAIT_L(8); PG8_BAR; PG8_WAIT_L(0); PG8_MMA(0, 0, At, B0); PG8_BAR; PG8_SCHED;
            PG8_LDB(B1, 0, 1); PG8_STAGE(PG8_SB(0, 0), b2, voffB);
            PG8_BAR; PG8_WAIT_L(0); PG8_MMA(0, 1, At, B1); PG8_BAR;
            PG8_LDA(At, 0, 1); PG8_STAGE(PG8_SA(0, 0), a2, voffA);
            PG8_BAR; PG8_WAIT_L(0); PG8_MMA(1, 0, At, B0); PG8_BAR; PG8_SCHED;
            PG8_STAGE(PG8_SB(0, 1), b2 + hstep, voffB);
            PG8_WAIT_V(6); PG8_BAR; PG8_MMA(1, 1, At, B1); PG8_BAR;
            PG8_LDB(B0, 1, 0); PG8_SCHED; PG8_LDA(At, 1, 0); PG8_STAGE(PG8_SA(0, 1), a2 + hstep, voffA);
            PG8_WAIT_L(8); PG8_BAR; PG8_WAIT_L(0); PG8_MMA(0, 0, At, B0); PG8_BAR; PG8_SCHED;
            PG8_LDB(B1, 1, 1); PG8_STAGE(PG8_SB(1, 0), b3, voffB);
            PG8_BAR; PG8_WAIT_L(0); PG8_MMA(0, 1, At, B1); PG8_BAR;
            PG8_LDA(At, 1, 1); PG8_STAGE(PG8_SA(1, 0), a3, voffA);
            PG8_BAR; PG8_WAIT_L(0); PG8_MMA(1, 0, At, B0); PG8_BAR; PG8_SCHED;
            PG8_STAGE(PG8_SB(1, 1), b3 + hstep, voffB);
            PG8_WAIT_V(6); PG8_BAR; PG8_MMA(1, 1, At, B1); PG8_BAR;
            }
        }
        if constexpr (ALIGN_EPI) { if (wr == 0) PG8_BAR; }
        if constexpr (FP8) asm volatile("s_nop 15\n\ts_nop 15" ::: "memory");
        if constexpr (!Epi::AFTER_DRAIN) { E(acc, cur, wr, wc, fr, fq); S.done(cur); }
        if (!has_next) break;
#pragma unroll
        for (int a = 0; a < 2; ++a)
#pragma unroll
            for (int b = 0; b < 2; ++b)
#pragma unroll
                for (int m = 0; m < 4; ++m)
#pragma unroll
                    for (int n = 0; n < 2; ++n) acc[a][b][m][n] = (f32x4){0.f, 0.f, 0.f, 0.f};
        cur = nxt; cA = nA; cB = nB; ++ui;
        if constexpr (ALIGN_EPI) { if (wr == 1) PG8_BAR; }
    }
    PG8_WAIT_V(0);
    if constexpr (!ALIGN_EPI) { if (wr == 0) PG8_BAR; }
    PG8_BAR;
    if constexpr (Epi::AFTER_DRAIN) { E.fused(acc, cur, wr, wc, fr, fq, lds, wid, lane); S.done(cur); }
#undef PG8_SA
#undef PG8_SB
#undef PG8_STAGE
#undef PG8_LDA
#undef PG8_LDB
#undef PG8_MMA
#undef PG8_WAIT_V
#undef PG8_WAIT_L
#undef PG8_BAR
#undef PG8_SCHED
}
}

namespace fox {
constexpr int D = 128, PITCH = 1024;
constexpr float THR = 8.f;
constexpr bool WSKIP = false;
constexpr float INV_SCALE = 11.313708498984761f;
constexpr float SCALE = 0.08838834764831845f;
constexpr int NW = 8, QBLK = 32, KVBLK = 64, QB = NW * QBLK;
constexpr int SHM_V = KVBLK * D * 2, SHM_K = KVBLK * D * 2;
constexpr int BIAS_OFF = 2 * SHM_V + 2 * SHM_K + NW * 64 * 4;
constexpr int LDS_BYTES = BIAS_OFF + 2 * 64 * 4;

typedef unsigned short bf16;
typedef short bf16x8 __attribute__((ext_vector_type(8)));
typedef short s16x4 __attribute__((ext_vector_type(4)));
typedef float f32x16 __attribute__((ext_vector_type(16)));
typedef float f32x4 __attribute__((ext_vector_type(4)));
typedef unsigned u32x4 __attribute__((ext_vector_type(4)));
template <class A, class Bt> struct same_t { static constexpr bool v = false; };
template <class A> struct same_t<A, A> { static constexpr bool v = true; };

#define KSWZ(row, colB) ((row) * 256 + ((colB) ^ (((row) & 7) << 4)))
#define SBAR() __builtin_amdgcn_sched_barrier(0)
__device__ __forceinline__ int v_st(int k, int c) { const int kk = (k & ~0xC) | ((k & 4) << 1) | ((k & 8) >> 1); return ((kk >> 3) * 4 + (c >> 5)) * 512 + ((kk & 7) * 32 + (c & 31)) * 2; }
__device__ __forceinline__ int v_rd_base(int lane) { return ((lane & 3) << 3) | (((lane >> 2) & 3) << 6) | (((lane >> 4) & 1) << 5) | (((lane >> 5) & 1) << 8); }
constexpr int v_rd_off(int d0, int ks, int half) { return d0 * 512 + ks * 4096 + half * 2048; }
__device__ __forceinline__ int crow(int r, int hi) { return (r & 3) + 8 * (r >> 2) + 4 * hi; }
__device__ __forceinline__ unsigned cvtpk(float lo, float hi) {
    unsigned r; asm volatile("v_cvt_pk_bf16_f32 %0, %1, %2" : "=v"(r) : "v"(lo), "v"(hi)); return r;
}
__device__ __forceinline__ bf16x8 pack8(f32x4 a, f32x4 b) {
    u32x4 w = {cvtpk(a[0], a[1]), cvtpk(a[2], a[3]), cvtpk(b[0], b[1]), cvtpk(b[2], b[3])};
    return *reinterpret_cast<bf16x8*>(&w);
}
template <class T> __device__ __forceinline__ bf16x8 load8(const T* p) {
    if constexpr (same_t<T, float>::v) { return pack8(*(const f32x4*)p, *(const f32x4*)(p + 4)); }
    else { return *reinterpret_cast<const bf16x8*>(p); }
}
__device__ __forceinline__ void mask_tile(f32x16& p0, f32x16& p1, int dq, unsigned W) {
    const float NEG = -__builtin_inff();
#pragma unroll
    for (int r = 0; r < 16; ++r) {
        const int c = (r & 3) + 8 * (r >> 2);
        if ((unsigned)(dq - c) >= W) p0[r] = NEG;
        if ((unsigned)(dq - c - 32) >= W) p1[r] = NEG;
    }
}
__device__ __forceinline__ void partialSM(f32x16& p0, f32x16& p1, float& m_reg, float& mn, float& alpha) {
    float pmax = p0[0]; for (int r = 1; r < 16; ++r) pmax = fmaxf(pmax, p0[r]); for (int r = 0; r < 16; ++r) pmax = fmaxf(pmax, p1[r]);
    { auto rr = __builtin_amdgcn_permlane32_swap(__float_as_uint(pmax), __float_as_uint(pmax), false, false);
      pmax = fmaxf(__uint_as_float(rr[0]), __uint_as_float(rr[1])); }
    constexpr float C2 = 1.4426950408889634f * SCALE;
    if (__builtin_expect(__all((pmax - m_reg) * SCALE <= THR), 1)) { mn = m_reg; alpha = 1.f; }
    else { mn = fmaxf(m_reg, pmax); alpha = __builtin_amdgcn_exp2f((m_reg - mn) * C2); m_reg = mn; }
    const float mnL = -mn * C2;
    for (int r = 0; r < 16; ++r) p0[r] = fmaf(p0[r], C2, mnL); for (int r = 0; r < 16; ++r) p1[r] = fmaf(p1[r], C2, mnL);
    for (int r = 0; r < 16; ++r) p0[r] = __builtin_amdgcn_exp2f(p0[r]);
}
__device__ __forceinline__ void finishSM(f32x16& p0, f32x16& p1, float alpha, float& l_reg, bf16x8& pa0, bf16x8& pa1, bf16x8& pa2, bf16x8& pa3) {
    for (int r = 0; r < 16; ++r) p1[r] = __builtin_amdgcn_exp2f(p1[r]);
    float ps = 0; for (int r = 0; r < 16; ++r) ps += p0[r]; for (int r = 0; r < 16; ++r) ps += p1[r];
    { auto rr = __builtin_amdgcn_permlane32_swap(__float_as_uint(ps), __float_as_uint(ps), false, false);
      ps = __uint_as_float(rr[0]) + __uint_as_float(rr[1]); }
    l_reg = l_reg * alpha + ps;
#define PK4(P, B_, OUT) do { unsigned a0 = cvtpk(P[B_+0], P[B_+1]), a1 = cvtpk(P[B_+2], P[B_+3]);                          \
        unsigned b0 = cvtpk(P[B_+4], P[B_+5]), b1 = cvtpk(P[B_+6], P[B_+7]);                                             \
        auto r0 = __builtin_amdgcn_permlane32_swap(a0, b0, false, false); auto r1 = __builtin_amdgcn_permlane32_swap(a1, b1, false, false); \
        u32x4 w = {r0[0], r1[0], r0[1], r1[1]}; OUT = *reinterpret_cast<bf16x8*>(&w); } while (0)
    PK4(p0, 0, pa0); PK4(p0, 8, pa1); PK4(p1, 0, pa2); PK4(p1, 8, pa3);
#undef PK4
}
template <int KB, bool SK>
__device__ __forceinline__ void qkt(f32x16& p0, f32x16& p1, const char* K_lds, int r32, int hi, const bf16x8* qr, bool act) {
    if (SK && !act) { const float NEG = -__builtin_inff();
#pragma unroll
        for (int r = 0; r < 16; ++r) { p0[r] = NEG; p1[r] = NEG; } return; }
    { const f32x4* bb = (const f32x4*)(K_lds + 2 * SHM_K + NW * 64 * 4 + KB * 256 + hi * 16);
#pragma unroll
      for (int g = 0; g < 4; ++g) { const f32x4 t0 = bb[2 * g], t1 = bb[8 + 2 * g];
#pragma unroll
          for (int i = 0; i < 4; ++i) { p0[4 * g + i] = t0[i]; p1[4 * g + i] = t1[i]; } } }
    const char* kb[4];
#pragma unroll
    for (int dd = 0; dd < 4; ++dd) kb[dd] = K_lds + KB * SHM_K + KSWZ(r32, (dd * 16 + hi * 8) * 2);
#pragma unroll
    for (int d0 = 0; d0 < 8; ++d0) { const char* a = kb[d0 & 3] + (d0 >> 2) * 128;
        bf16x8 b0 = *reinterpret_cast<const bf16x8*>(a);
        bf16x8 b1 = *reinterpret_cast<const bf16x8*>(a + 32 * 256);
        p0 = __builtin_amdgcn_mfma_f32_32x32x16_bf16(b0, qr[d0], p0, 0, 0, 0);
        p1 = __builtin_amdgcn_mfma_f32_32x32x16_bf16(b1, qr[d0], p1, 0, 0, 0); }
}
template <int VB, bool SK>
__device__ __forceinline__ void pv_tile(f32x16* o, int vb0, bf16x8 pa0, bf16x8 pa1, bf16x8 pa2, bf16x8 pa3, bool act) {
    if (SK && !act) return;
#define TRRD(dst, off) asm volatile("ds_read_b64_tr_b16 %0, %1 offset:%2" : "=&v"(dst) : "v"(vb0), "i"(off) : "memory")
#define PV_D0(d0) do { s16x4 l0, l1, l2, l3, h0, h1, h2, h3; constexpr int b_ = VB * SHM_V + v_rd_off(d0, 0, 0);     \
        TRRD(l0, b_); TRRD(h0, b_ + 2048); TRRD(l1, b_ + 4096); TRRD(h1, b_ + 6144); TRRD(l2, b_ + 8192); TRRD(h2, b_ + 10240); TRRD(l3, b_ + 12288); TRRD(h3, b_ + 14336); \
        asm volatile("s_waitcnt lgkmcnt(0)" ::: "memory"); SBAR();                 \
        o[d0] = __builtin_amdgcn_mfma_f32_32x32x16_bf16(pa0, (bf16x8){l0[0], l0[1], l0[2], l0[3], h0[0], h0[1], h0[2], h0[3]}, o[d0], 0, 0, 0);   \
        o[d0] = __builtin_amdgcn_mfma_f32_32x32x16_bf16(pa1, (bf16x8){l1[0], l1[1], l1[2], l1[3], h1[0], h1[1], h1[2], h1[3]}, o[d0], 0, 0, 0);   \
        o[d0] = __builtin_amdgcn_mfma_f32_32x32x16_bf16(pa2, (bf16x8){l2[0], l2[1], l2[2], l2[3], h2[0], h2[1], h2[2], h2[3]}, o[d0], 0, 0, 0);   \
        o[d0] = __builtin_amdgcn_mfma_f32_32x32x16_bf16(pa3, (bf16x8){l3[0], l3[1], l3[2], l3[3], h3[0], h3[1], h3[2], h3[3]}, o[d0], 0, 0, 0); } while (0)
    PV_D0(0); PV_D0(1); PV_D0(2); PV_D0(3);
#undef PV_D0
#undef TRRD
}

template <class TIn, class TOut> struct BlockRef { const TIn* Q; const TIn* K; const TIn* V; TOut* O; const float* cb; float cref; int P0; int jlo; };
template <class TIn> struct Seam {
    bf16x8 qr[8];
    bf16x8 st_v0, st_v1, st_k0, st_k1; float st_c; f32x4 sf0, sf1, sf2, sf3;
    f32x4 tq[16];
};
__device__ __forceinline__ int swa_jlo(int P0, int W) { const int lowk = P0 - W + 1; return lowk > 0 ? lowk / KVBLK : 0; }
#define ROW(p, k0, rr) ((p) + (size_t)((k0) + (rr)) * PITCH + sc)
#define VMW() asm volatile("s_waitcnt vmcnt(0)" ::: "memory")
#define VMWN(n) asm volatile("s_waitcnt vmcnt(%0)" :: "i"(n) : "memory")
#define SLOAD_H(Kp, Vp, Cp, k0) do { S.st_v0 = load8<TIn>(ROW(Vp, k0, sr)); S.st_v1 = load8<TIn>(ROW(Vp, k0, 32 + sr));              \
                         S.st_k0 = load8<TIn>(ROW(Kp, k0, sr)); S.st_k1 = load8<TIn>(ROW(Kp, k0, 32 + sr)); S.st_c = (Cp)[(k0) + lane]; } while (0)
#define SWRITE_HK(bf, cr) do { *(bf16x8*)(K_lds + (bf) * SHM_K + kws) = S.st_k0; *(bf16x8*)(K_lds + (bf) * SHM_K + kws + 32 * 256) = S.st_k1; \
                            if (wid == 0) ((float*)(K_lds + 2 * SHM_K + NW * 64 * 4))[(bf) * 64 + lane] = ((cr) - S.st_c) * INV_SCALE; } while (0)
#define SWRITE_HV(bf) do { *(bf16x8*)(V_lds + (bf) * SHM_V + vst0) = S.st_v0; *(bf16x8*)(V_lds + (bf) * SHM_V + vst1) = S.st_v1; } while (0)
#define SWRITE_H(bf, cr) do { SWRITE_HV(bf); SWRITE_HK(bf, cr); } while (0)
#define SLOAD_F(p, k0) do { S.sf0 = *(const f32x4*)ROW(p, k0, sr); S.sf1 = *(const f32x4*)(ROW(p, k0, sr) + 4);                \
                            S.sf2 = *(const f32x4*)ROW(p, k0, 32 + sr); S.sf3 = *(const f32x4*)(ROW(p, k0, 32 + sr) + 4); } while (0)
#define SWRITE_KF(bf) do { *(bf16x8*)(K_lds + (bf) * SHM_K + kws) = pack8(S.sf0, S.sf1); *(bf16x8*)(K_lds + (bf) * SHM_K + kws + 32 * 256) = pack8(S.sf2, S.sf3); } while (0)
#define SWRITE_VF(bf) do { *(bf16x8*)(V_lds + (bf) * SHM_V + vst0) = pack8(S.sf0, S.sf1); *(bf16x8*)(V_lds + (bf) * SHM_V + vst1) = pack8(S.sf2, S.sf3); } while (0)
template <class TIn, class TOut>
__device__ __forceinline__ void causal_swa_prime(const BlockRef<TIn, TOut>& cur, int W, char* lds, Seam<TIn>& S, const int wave_in  ) {
    constexpr bool F32 = same_t<TIn, float>::v;
    const int tid = pg8::opaque_tid(wave_in), wid = __builtin_amdgcn_readfirstlane(tid >> 6), lane = tid & 63, r32 = lane & 31, hi = lane >> 5;
    const int sr = tid >> 4, sc = (tid & 15) * 8, kws = KSWZ(sr, sc * 2); char* K_lds = lds + 2 * SHM_V;
    const int kb0 = cur.jlo * KVBLK;
    for (int d0 = 0; d0 < 8; ++d0) S.qr[d0] = load8<TIn>(cur.Q + (size_t)(wid * QBLK + r32) * PITCH + d0 * 16 + hi * 8);
    if constexpr (F32) { SLOAD_F((const float*)cur.K, kb0); VMW(); SWRITE_KF(0); SBAR(); SLOAD_F((const float*)cur.V, kb0); }
    else { SLOAD_H(cur.K, cur.V, cur.cb, kb0); VMW(); SWRITE_HK(0, cur.cref); }
    __syncthreads();
}
template <class TIn, class TOut>
__device__ __forceinline__ void causal_swa_block(const BlockRef<TIn, TOut>& cur, const BlockRef<TIn, TOut>& nxt, int skv, int W, char* lds, Seam<TIn>& S, const int wave_in  ) {
    constexpr bool F32 = same_t<TIn, float>::v;
    const int tid = pg8::opaque_tid(wave_in), wid = __builtin_amdgcn_readfirstlane(tid >> 6), lane = tid & 63, r32 = lane & 31, hi = lane >> 5;
    const int j_lo = cur.jlo;
    int j_hi = (cur.P0 + QB - 1) / KVBLK + 1; if (j_hi > skv / KVBLK) j_hi = skv / KVBLK;
    const int NT = j_hi - j_lo;
    const int kbn = nxt.jlo * KVBLK;
    const int qlo = cur.P0 + wid * QBLK, qm = qlo + r32 - 4 * hi;
    char* V_lds = lds; char* K_lds = lds + 2 * SHM_V;
    float* ws = (float*)(lds + 2 * SHM_V + 2 * SHM_K) + wid * 64; float* li_l = ws, * al_l = ws + 32;
    float m_reg = -1e30f, l_reg = 0; f32x16 o[4] = {};
    const int sr = tid >> 4, sc = (tid & 15) * 8, vst0 = v_st(sr, sc), vst1 = v_st(32 + sr, sc), kws = KSWZ(sr, sc * 2);
    const int vb0 = (int)(uintptr_t)V_lds + v_rd_base(lane);
    const TIn* Kh = cur.K; const TIn* Vh = cur.V;
#define RESC(a) do { if (__any((a) < 1.f)) { if (hi == 0) al_l[r32] = (a); asm volatile("s_waitcnt lgkmcnt(0)" ::: "memory");              \
                     for (int d_ = 0; d_ < 4; ++d_) for (int r = 0; r < 16; ++r) o[d_][r] *= al_l[crow(r, hi)]; } } while (0)
#define KBASE(t) ((j_lo + (t)) * KVBLK)
#define ACT(t) (KBASE(t) <= qlo + QBLK - 1 && KBASE(t) + KVBLK - 1 >= qlo - W + 1)
#define MASKT(P0_, P1_, t) do { const int kb_ = KBASE(t); if ((!SK || ACT(t)) && (kb_ + KVBLK - 1 > qlo || kb_ <= qlo + QBLK - 1 - W)) mask_tile(P0_, P1_, qm - kb_, (unsigned)W); } while (0)
    constexpr int NQL = F32 ? 16 : 8;
    constexpr bool SK = WSKIP && !F32;
#define SEAM_K0() do { VMWN(NQL); if constexpr (F32) { SWRITE_KF(0); SBAR(); SLOAD_F((const float*)nxt.V, kbn); } else { SWRITE_HK(0, nxt.cref); } SBAR(); } while (0)
    f32x16 pA0, pA1, pB0, pB1; float mnA, mnB, alA, alB; bf16x8 pa0, pa1, pa2, pa3;
    if constexpr (F32) { VMW(); SWRITE_VF(0); SBAR(); } else { SWRITE_HV(0); SBAR(); }
    if (NT > 1) { if constexpr (F32) SLOAD_F((const float*)Kh, KBASE(1)); else SLOAD_H(Kh, Vh, cur.cb, KBASE(1)); }
    SBAR(); qkt<0, SK>(pA0, pA1, K_lds, r32, hi, S.qr, ACT(0));
    if constexpr (F32) { if (NT > 1) { VMW(); SWRITE_KF(1); SBAR(); SLOAD_F((const float*)Vh, KBASE(1)); } }
    MASKT(pA0, pA1, 0); partialSM(pA0, pA1, m_reg, mnA, alA);
    if (NT > 1) { VMW(); if constexpr (F32) { SWRITE_VF(1); SBAR(); if (NT > 2) SLOAD_F((const float*)Kh, KBASE(2)); } else SWRITE_H(1, cur.cref); }
    __syncthreads();
#define HALF_STEP(PX0, PX1, mnX, alX, PY0, PY1, alY, t, KB, VB, SB) do {                                                      \
        SBAR(); qkt<KB, SK>(PX0, PX1, K_lds, r32, hi, S.qr, ACT(t));                                             \
        finishSM(PY0, PY1, alY, l_reg, pa0, pa1, pa2, pa3); SBAR();                                                           \
        if ((t) + 1 < NT) { if constexpr (F32) { VMW(); SWRITE_KF(SB); SBAR(); SLOAD_F((const float*)Vh, KBASE((t) + 1)); }  \
                            else { SLOAD_H(Kh, Vh, cur.cb, KBASE((t) + 1)); } SBAR(); }                                               \
        pv_tile<VB, SK>(o, vb0, pa0, pa1, pa2, pa3, ACT((t) - 1)); MASKT(PX0, PX1, (t)); partialSM(PX0, PX1, m_reg, mnX, alX);                                        \
        __syncthreads();                                                                                                      \
        if ((t) + 1 < NT) { VMW(); if constexpr (F32) { SWRITE_VF(SB); SBAR(); if ((t) + 2 < NT) SLOAD_F((const float*)Kh, KBASE((t) + 2)); } \
                            else { SWRITE_H(SB, cur.cref); } }                                                                          \
        RESC(alX); __syncthreads(); } while (0)
    for (int t = 1; t + 1 < NT; t += 2) {
        HALF_STEP(pB0, pB1, mnB, alB, pA0, pA1, alA, t, 1, 0, 0);
        HALF_STEP(pA0, pA1, mnA, alA, pB0, pB1, alB, t + 1, 0, 1, 1);
    }
    const bool even = (NT & 1) == 0;
    if (even) { SBAR(); qkt<1, SK>(pB0, pB1, K_lds, r32, hi, S.qr, ACT(NT - 1)); SBAR(); }
#define QROW(e) (nxt.Q + (size_t)(wid * QBLK + r32) * PITCH + ((e) >> 1) * 16 + hi * 8 + ((e) & 1) * 4)
    if constexpr (F32) { SLOAD_F((const float*)nxt.K, kbn); SBAR();
#pragma unroll
        for (int e = 0; e < 8; ++e) S.tq[e] = *(const f32x4*)QROW(e); }
    else { SLOAD_H(nxt.K, nxt.V, nxt.cb, kbn); SBAR();
#pragma unroll
        for (int d0 = 0; d0 < 8; ++d0) S.qr[d0] = load8<TIn>(nxt.Q + (size_t)(wid * QBLK + r32) * PITCH + d0 * 16 + hi * 8); }
    SBAR();
    finishSM(pA0, pA1, alA, l_reg, pa0, pa1, pa2, pa3); SBAR();
    if constexpr (F32) {
#pragma unroll
        for (int e = 8; e < 16; ++e) S.tq[e] = *(const f32x4*)QROW(e); SBAR(); }
#undef QROW
    pv_tile<0, SK>(o, vb0, pa0, pa1, pa2, pa3, ACT(even ? NT - 2 : NT - 1));
    if (even) { MASKT(pB0, pB1, NT - 1); partialSM(pB0, pB1, m_reg, mnB, alB); __syncthreads(); RESC(alB);
        finishSM(pB0, pB1, alB, l_reg, pa0, pa1, pa2, pa3); SBAR(); pv_tile<1, SK>(o, vb0, pa0, pa1, pa2, pa3, ACT(NT - 1)); }
    SBAR(); SEAM_K0();
    if (hi == 0) li_l[r32] = l_reg; asm volatile("s_waitcnt lgkmcnt(0)" ::: "memory");
    float rli[16];
#pragma unroll
    for (int r = 0; r < 16; ++r) rli[r] = __builtin_amdgcn_rcpf(li_l[crow(r, hi)]);
    TOut* Ow = cur.O + (size_t)(wid * QBLK) * PITCH;
#pragma unroll
    for (int r = 0; r < 16; ++r) { const int orow = crow(r, hi);
#pragma unroll
        for (int d0 = 0; d0 < 4; ++d0) { const float v = o[d0][r] * rli[r];
            if constexpr (same_t<TOut, float>::v) { Ow[(size_t)orow * PITCH + d0 * 32 + r32] = v; }
            else { const float vn = __int_as_float(__builtin_amdgcn_update_dpp(0, __float_as_int(v), 0xB1  , 0xF, 0xF, false));
                   if ((r32 & 1) == 0) *(unsigned*)(Ow + (size_t)orow * PITCH + d0 * 32 + r32) = cvtpk(v, vn); } } }
    if constexpr (F32) {
#pragma unroll
        for (int d0 = 0; d0 < 8; ++d0) S.qr[d0] = pack8(S.tq[2 * d0], S.tq[2 * d0 + 1]); }
    __syncthreads();
#undef RESC
#undef KBASE
#undef ACT
#undef MASKT
#undef SEAM_K0
#undef HALF_STEP
}
#undef ROW
#undef VMW
#undef VMWN
#undef SLOAD_H
#undef SWRITE_HK
#undef SWRITE_HV
#undef SWRITE_H
#undef SLOAD_F
#undef SWRITE_KF
#undef SWRITE_VF

}

#define GAS __attribute__((address_space(1)))
#define LAS __attribute__((address_space(3)))
typedef unsigned short bf16;
typedef unsigned v4u __attribute__((ext_vector_type(4)));
typedef float f32x4 __attribute__((ext_vector_type(4)));
typedef short bf16x8 __attribute__((ext_vector_type(8)));
typedef GAS unsigned gu32;
typedef GAS unsigned long long gu64;
#define RLX_AGENT __ATOMIC_RELAXED, __HIP_MEMORY_SCOPE_AGENT
#define LDS_WAIT() asm volatile("s_waitcnt lgkmcnt(0)" ::: "memory")
#define VM_WAIT() asm volatile("s_waitcnt vmcnt(0)" ::: "memory")
__device__ __forceinline__ unsigned long long rt() { return __builtin_amdgcn_s_memrealtime(); }
__device__ __forceinline__ unsigned f2bf(float f) { unsigned u = __builtin_bit_cast(unsigned, f); return (u + 0x7fffu + ((u >> 16) & 1u)) >> 16; }
__device__ __forceinline__ unsigned pk2(float lo, float hi) { return f2bf(lo) | (f2bf(hi) << 16); }

#define XB_TMO      128
#define XB_XCNT(j)  (256  + 64 * (j))
#define XB_XSUB(j)  (1280 + 64 * (j))
#define XB_XGEN(j)  (2304 + 64 * (j))
#define XB_TOP      3328
#define XB_TOPGEN   3392
#define XCD_BAR_WORDS 3456
#define XB_SPIN_CAP (1u << 21)

__device__ __forceinline__ unsigned xb_ld(unsigned* p)              { return __hip_atomic_load(p, __ATOMIC_RELAXED, __HIP_MEMORY_SCOPE_AGENT); }
__device__ __forceinline__ unsigned xb_add(unsigned* p, unsigned v) { return __hip_atomic_fetch_add(p, v, __ATOMIC_RELAXED, __HIP_MEMORY_SCOPE_AGENT); }
__device__ __forceinline__ unsigned xb_xcc_id() { return (unsigned)__builtin_amdgcn_s_getreg((3 << 11) | 20) & 0xFu; }
#define XB_SPIN(cond, bar) do { unsigned _sp = 0; while (cond) { __builtin_amdgcn_s_sleep(1); \
    if ((++_sp & 255u) == 0u) { if (xb_ld(&(bar)[XB_TMO])) break; if (_sp > XB_SPIN_CAP) { atomicAdd(&(bar)[XB_TMO], 1u); break; } } } } while (0)

struct XcdBarrier {
    unsigned* bar; unsigned x;
    volatile LAS unsigned* st;
};

__device__ __forceinline__ XcdBarrier xcd_barrier_post(unsigned* bar, volatile LAS unsigned* st) {
    XcdBarrier b; b.bar = bar; b.x = xb_xcc_id(); b.st = st;
    if (threadIdx.x == 0) (void)xb_add(&bar[XB_XCNT(b.x)], 1u);
    return b;
}
__device__ __forceinline__ void xcd_barrier_complete(unsigned* bar, unsigned x, unsigned& nloc, unsigned& nx) {
    const unsigned G = gridDim.x * gridDim.y * gridDim.z;
    unsigned sum, cnt, mine, sp = 0u;
    for (;;) {
        sum = 0u; cnt = 0u; mine = 0u;
#pragma unroll
        for (unsigned j = 0; j < 16; ++j) { const unsigned c = xb_ld(&bar[XB_XCNT(j)]); sum += c; cnt += (c > 0u) ? 1u : 0u; mine = (j == x) ? c : mine; }
        if (sum == G) break;
        __builtin_amdgcn_s_sleep(1);
        if ((++sp & 255u) == 0u) { if (xb_ld(&bar[XB_TMO])) break; if (sp > XB_SPIN_CAP) { atomicAdd(&bar[XB_TMO], 1u); break; } }
    }
    nloc = mine > 0u ? mine : 1u; nx = cnt > 0u ? cnt : 1u;
}

__device__ __forceinline__ void xcd_barrier(const XcdBarrier& b) {
    asm volatile("s_waitcnt vmcnt(0)" ::: "memory");
    __syncthreads();
    if (threadIdx.x == 0) {
        unsigned* bar = b.bar;
        __builtin_amdgcn_s_waitcnt(0);
        unsigned nloc = b.st[0], nx = b.st[1];
        if (nloc == 0u) { xcd_barrier_complete(bar, b.x, nloc, nx); b.st[0] = nloc; b.st[1] = nx; }
        const unsigned old = xb_add(&bar[XB_XSUB(b.x)], 1u);
        const unsigned gen = old / nloc;
        if (old + 1u == (gen + 1u) * nloc) {
            __builtin_amdgcn_fence(__ATOMIC_RELEASE, "agent");
            asm volatile("s_waitcnt vmcnt(0)" ::: "memory");
            const unsigned og = xb_add(&bar[XB_TOP], 1u);
            const unsigned tg = og / nx;
            if (og + 1u == (tg + 1u) * nx) xb_add(&bar[XB_TOPGEN], 1u);
            else XB_SPIN(xb_ld(&bar[XB_TOPGEN]) == tg, bar);
            __builtin_amdgcn_fence(__ATOMIC_ACQUIRE, "agent");
            xb_add(&bar[XB_XGEN(b.x)], 1u);
            asm volatile("s_waitcnt vmcnt(0)" ::: "memory");
        } else {
            XB_SPIN(xb_ld(&bar[XB_XGEN(b.x)]) == gen, bar);
            __builtin_amdgcn_fence(__ATOMIC_ACQUIRE, "agent");
            asm volatile("s_waitcnt vmcnt(0)" ::: "memory");
        }
    }
    __syncthreads();
}

constexpr int NWAVES = 8;
#ifndef MK_PER_PHASE
#define MK_PER_PHASE 0
#endif
constexpr int BATCH = 2, SEQ = 16384, DM = 2048, MTOK = BATCH * SEQ;
constexpr int DCONV = 1024, NH = 8, DATT = 1024, PTOT = 10248, NPROJ = 10240;
constexpr int DFF = 5632, NE = 8, DFFE = 7168;
constexpr int RMAX = MTOK + NE * 256;
constexpr float RMS_EPS = 1e-6f;
constexpr size_t MiB = 1u << 20;
constexpr size_t WS_CTL = 0, CTL_ZERO_BYTES = 1 * MiB;
constexpr size_t WS_LOGF = 1 * MiB;
constexpr size_t WS_CB = 2 * MiB;
constexpr size_t WS_TOKE = 3 * MiB;
constexpr size_t WS_TOKW = 3 * MiB + 512 * 1024;
constexpr size_t WS_ROWTOK = 4 * MiB;
constexpr size_t WS_ROWW = 5 * MiB;
constexpr size_t WS_WIN = 8 * MiB;
constexpr size_t WS_WCO = WS_WIN + 80 * MiB;
constexpr size_t WS_WAO = WS_WCO + 8 * MiB;
constexpr size_t WS_WO = WS_WAO + 8 * MiB;
constexpr size_t WS_WGU = WS_WO + 16 * MiB;
constexpr size_t WS_WDD = WS_WGU + 44 * MiB;
constexpr size_t WS_MWGU = WS_WDD + 22 * MiB;
constexpr size_t WS_MWD = WS_MWGU + 448 * MiB;
constexpr size_t WS_A = WS_MWD + 224 * MiB;
constexpr size_t WS_P6 = WS_A + 128 * MiB;
constexpr size_t WS_G = WS_P6 + 384 * MiB;
constexpr size_t WS_END = WS_G + 256 * MiB;
constexpr size_t WS_HID = WS_P6;
constexpr size_t WS_XG = WS_P6 + 476 * MiB;
static_assert((size_t)RMAX * DFFE * 2 <= 476 * MiB && WS_XG + (size_t)RMAX * DM * 2 <= WS_END && (size_t)MTOK * DFF * 2 <= 476 * MiB, "overlay");
static_assert((size_t)2 * NPROJ * DM * 2 == 80 * MiB && (size_t)2 * DFF * DM * 2 == 44 * MiB && (size_t)NE * 2 * DFFE * DM * 2 == 448 * MiB, "weights");
constexpr int CW_CNT = 64;
constexpr int CW_CUR = 128;
constexpr int CW_NMAX = 192;
constexpr int CW_BQ = 8192;
constexpr int CW_BD = 8192 + 2048;
constexpr int CW_BAR = 4096;
constexpr int RING_BYTES = 131072;
constexpr int LDSCTL_OFF = RING_BYTES, MISC_OFF = LDSCTL_OFF + 320, TILE_E_OFF = LDSCTL_OFF + 1024, JLO_OFF = LDSCTL_OFF + 2048;
constexpr float PRUNE_T = 26.5f;
constexpr int LDS_BYTES = 147456;
enum { I_X = 0, I_MIXN, I_WIN, I_BF, I_CONVW, I_WCO, I_WAO, I_WO, I_FFNN, I_DWG, I_DWU, I_DWD, I_RW, I_RB, I_MWG, I_MWU, I_MWD, I_FN, N_IN };

struct Args { const float* in[N_IN]; float* out; unsigned char* ws; int ph_lo, ph_hi; };
struct Frame { LAS unsigned char* lds; int tid, lane, wave, vcu, G; };
#define KAS __attribute__((address_space(4)))
typedef const KAS Args* ArgsP;

__device__ __forceinline__ float wave_sum(float v, int lane) {
#pragma unroll
    for (int o = 1; o < 64; o <<= 1) v += __int_as_float(__builtin_amdgcn_ds_bpermute((lane ^ o) << 2, __float_as_int(v)));
    return v;
}
struct CvtJob { const float* src; bf16* dst; int ldw, col_off, ncols, K, kind, row_off, fp8; };
__device__ __forceinline__ void get_job(ArgsP a, int j, CvtJob& J) {
    J.fp8 = 0;
    if (j < 4) { const int l = j >> 1, p = j & 1; J.src = a->in[I_WIN] + (size_t)l * DM * PTOT; J.ldw = PTOT; J.col_off = p ? 6152 : 0; J.ncols = p ? 4096 : 6144; J.K = DM;
        J.dst = (bf16*)(a->ws + WS_WIN) + (size_t)l * NPROJ * DM; J.kind = 0; J.row_off = p ? 6144 : 0; }
    else if (j < 8) { const int l = j & 1, w = (j - 4) >> 1; J.src = a->in[w ? I_WAO : I_WCO] + (size_t)l * 1024 * DM; J.ldw = DM; J.col_off = 0; J.ncols = DM; J.K = 1024;
        J.dst = (bf16*)(a->ws + (w ? WS_WAO : WS_WCO)) + (size_t)l * DM * 1024; J.kind = 0; J.row_off = 0; }
    else if (j < 10) { const int l = j & 1; J.src = a->in[I_WO] + (size_t)l * DM * DM; J.ldw = DM; J.col_off = 0; J.ncols = DM; J.K = DM; J.dst = (bf16*)(a->ws + WS_WO) + (size_t)l * DM * DM; J.kind = 0; J.row_off = 0; }
    else if (j < 12) { const int u = j - 10; J.src = a->in[u ? I_DWU : I_DWG]; J.ldw = DFF; J.col_off = 0; J.ncols = DFF; J.K = DM; J.dst = (bf16*)(a->ws + WS_WGU); J.kind = 1; J.row_off = u ? 128 : 0; }
    else if (j < 13) { J.src = a->in[I_DWD]; J.ldw = DM; J.col_off = 0; J.ncols = DM; J.K = DFF; J.dst = (bf16*)(a->ws + WS_WDD); J.kind = 0; J.row_off = 0; }
    else if (j < 29) { const int e = (j - 13) & 7, u = (j - 13) >> 3; J.src = a->in[u ? I_MWU : I_MWG] + (size_t)e * DM * DFFE; J.ldw = DFFE; J.col_off = 0; J.ncols = DFFE; J.K = DM;
        J.dst = (bf16*)(a->ws + WS_MWGU + (size_t)e * 2 * DFFE * DM); J.kind = 1; J.row_off = u ? 128 : 0; J.fp8 = 1; }
    else { const int e = j - 29; J.src = a->in[I_MWD] + (size_t)e * DFFE * DM; J.ldw = DM; J.col_off = 0; J.ncols = DM; J.K = DFFE; J.dst = (bf16*)(a->ws + WS_MWD + (size_t)e * DM * DFFE); J.kind = 0; J.row_off = 0; J.fp8 = 1; }
}
constexpr int N_CVT_JOBS = 37;
__device__ __forceinline__ void cvt_item(const CvtJob& J, int item, int lane) {
    const int nblk = J.ncols >> 5, kb = item / nblk, nb = item - kb * nblk;
    const int kq = lane >> 3, n4 = lane & 7;
    const float* s = J.src + (size_t)(kb * 64 + kq * 8) * J.ldw + J.col_off + nb * 32 + n4 * 4;
    f32x4 v[8];
#pragma unroll
    for (int e = 0; e < 8; ++e) v[e] = *(const GAS f32x4*)(s + (size_t)e * J.ldw);
    const int src_lane = ((lane & 7) << 3) | (lane >> 3);
    unsigned w[4][4];
#pragma unroll
    for (int j = 0; j < 4; ++j)
#pragma unroll
        for (int q = 0; q < 4; ++q) w[j][q] = (unsigned)__builtin_amdgcn_ds_bpermute(src_lane << 2, (int)pk2(v[2 * q][j], v[2 * q + 1][j]));
    const int n0 = nb * 32 + (lane >> 3) * 4, k0 = kb * 64 + (lane & 7) * 8;
    const int drow = (J.kind == 1 ? 256 * (n0 >> 7) + (n0 & 127) : n0) + J.row_off;
#pragma unroll
    for (int j = 0; j < 4; ++j) { v4u o; o.x = w[j][0]; o.y = w[j][1]; o.z = w[j][2]; o.w = w[j][3]; *(GAS v4u*)(J.dst + (size_t)(drow + j) * J.K + k0) = o; }
}
__device__ __forceinline__ void cvt_item8(const CvtJob& J, int item, int lane) {
    const int nblk = J.ncols >> 5, kb = item / nblk, nb = item - kb * nblk;
    const int kq = lane >> 3, n4 = lane & 7;
    const float* s = J.src + (size_t)(kb * 128 + kq * 16) * J.ldw + J.col_off + nb * 32 + n4 * 4;
    f32x4 v[16];
#pragma unroll
    for (int e = 0; e < 16; ++e) v[e] = *(const GAS f32x4*)(s + (size_t)e * J.ldw);
    const int src_lane = ((lane & 7) << 3) | (lane >> 3);
    unsigned w[4][4];
#pragma unroll
    for (int j = 0; j < 4; ++j)
#pragma unroll
        for (int q = 0; q < 4; ++q) w[j][q] = (unsigned)__builtin_amdgcn_ds_bpermute(src_lane << 2, (int)pg8::pk4_fp8(v[4 * q][j] * pg8::F8_WS, v[4 * q + 1][j] * pg8::F8_WS, v[4 * q + 2][j] * pg8::F8_WS, v[4 * q + 3][j] * pg8::F8_WS));
    const int n0 = nb * 32 + (lane >> 3) * 4, k0 = kb * 128 + (lane & 7) * 16;
    const int drow = (J.kind == 1 ? 256 * (n0 >> 7) + (n0 & 127) : n0) + J.row_off;
    unsigned char* d8 = (unsigned char*)J.dst;
#pragma unroll
    for (int j = 0; j < 4; ++j) { v4u o; o.x = w[j][0]; o.y = w[j][1]; o.z = w[j][2]; o.w = w[j][3]; *(GAS v4u*)(d8 + (size_t)(drow + j) * J.K + k0) = o; }
}
__device__ __forceinline__ void phase_convert(const Frame& F, ArgsP a) {
    const int gw = F.vcu * NWAVES + F.wave, NGW = F.G * NWAVES; int off = 0;
    for (int j = 0; j < N_CVT_JOBS; ++j) { CvtJob J; get_job(a, j, J); const int nit = (J.fp8 ? (J.K >> 7) : (J.K >> 6)) * (J.ncols >> 5);
        int i0 = (gw - off) % NGW; if (i0 < 0) i0 += NGW;
        if (J.fp8) { for (int it = i0; it < nit; it += NGW) cvt_item8(J, it, F.lane); } else { for (int it = i0; it < nit; it += NGW) cvt_item(J, it, F.lane); }
        off = (off + nit) % NGW; }
}
__device__ __forceinline__ float log_sigmoid(float x) {
    const float y = __builtin_amdgcn_exp2f(-1.4426950408889634f * __builtin_fabsf(x));
    const float l1p = y < 1e-3f ? y * (1.0f - 0.5f * y) : 0.6931471805599453f * __builtin_amdgcn_logf(1.0f + y);
    return fminf(x, 0.f) - l1p;
}
__device__ __forceinline__ void stage_w8(const Frame& F, const float* w8, int ldw) {
    LAS float* wl = (LAS float*)F.lds;
    for (int col = F.tid; col < DM; col += NWAVES * 64) { const int j = col >> 8, ln = (col & 255) >> 2, e = col & 3;
        const f32x4 a = *(const GAS f32x4*)(w8 + (size_t)col * ldw), b = *(const GAS f32x4*)(w8 + (size_t)col * ldw + 4);
        LAS f32x4* d = (LAS f32x4*)(wl + ((j * 4 + e) * 64 + ln) * 8); d[0] = a; d[1] = b; }
    __syncthreads();
}
template <int MODE>
__device__ __forceinline__ void phase_norm(const Frame& F, ArgsP a, const float* hin, const float* gain, bf16* aout, float* fout, const float* w8, int ldw8, const float* b8) {
    if (MODE == 0 || MODE == 2) stage_w8(F, w8, ldw8);
    const LAS float* wl = (const LAS float*)F.lds;
    f32x4 g[8];
#pragma unroll
    for (int j = 0; j < 8; ++j) g[j] = *(const GAS f32x4*)(gain + 256 * j + 4 * F.lane);
    float bb[8];
#pragma unroll
    for (int h = 0; h < 8; ++h) bb[h] = (MODE == 0 || MODE == 2) ? b8[h] : 0.f;
    const int RPW = MTOK / (F.G * NWAVES);
    const int gw = F.vcu * NWAVES + F.wave; const int r0 = gw * RPW;
    float* logf = (float*)(a->ws + WS_LOGF); int* tokE = (int*)(a->ws + WS_TOKE); float* tokW = (float*)(a->ws + WS_TOKW);
    int mycnt = 0;
    for (int r = r0; r < r0 + RPW; ++r) {
        const GAS f32x4* xr = (const GAS f32x4*)(hin + (size_t)r * DM) + F.lane;
        f32x4 v[8]; float ss = 0.f;
#pragma unroll
        for (int j = 0; j < 8; ++j) { v[j] = xr[64 * j]; ss += (v[j].x * v[j].x + v[j].y * v[j].y) + (v[j].z * v[j].z + v[j].w * v[j].w); }
        const float rstd = 1.0f / sqrtf(wave_sum(ss, F.lane) * (1.0f / DM) + RMS_EPS);
#pragma unroll
        for (int j = 0; j < 8; ++j) v[j] = v[j] * rstd * g[j];
        if (MODE == 3) { GAS f32x4* o = (GAS f32x4*)(fout + (size_t)r * DM) + F.lane;
#pragma unroll
            for (int j = 0; j < 8; ++j) o[64 * j] = v[j]; }
        else { GAS unsigned long long* o8 = (GAS unsigned long long*)(aout + (size_t)r * DM) + F.lane;
#pragma unroll
            for (int j = 0; j < 8; ++j) o8[64 * j] = (unsigned long long)pk2(v[j].x, v[j].y) | ((unsigned long long)pk2(v[j].z, v[j].w) << 32); }
        if (MODE == 0 || MODE == 2) {
            float acc[8];
#pragma unroll
            for (int h = 0; h < 8; ++h) acc[h] = 0.f;
#pragma unroll
            for (int j = 0; j < 8; ++j) { asm volatile("" ::: "memory");
#pragma unroll
                for (int e = 0; e < 4; ++e) { const LAS f32x4* wp = (const LAS f32x4*)(wl + ((j * 4 + e) * 64 + F.lane) * 8); const f32x4 w0 = wp[0], w1 = wp[1]; const float x = v[j][e];
                    acc[0] += x * w0.x; acc[1] += x * w0.y; acc[2] += x * w0.z; acc[3] += x * w0.w; acc[4] += x * w1.x; acc[5] += x * w1.y; acc[6] += x * w1.z; acc[7] += x * w1.w; } }
#pragma unroll
            for (int h = 0; h < 8; ++h) acc[h] = wave_sum(acc[h], F.lane) + bb[h];
            if (MODE == 0) {
                float mine = acc[0];
#pragma unroll
                for (int h = 1; h < 8; ++h) mine = (F.lane == h) ? acc[h] : mine;
                if (F.lane < 8) logf[(size_t)r * 8 + F.lane] = log_sigmoid(mine);
            } else {
                int i1 = 0; float l1 = acc[0];
#pragma unroll
                for (int h = 1; h < 8; ++h) if (acc[h] > l1) { l1 = acc[h]; i1 = h; }
                int i2 = -1; float l2 = -3.0e38f;
#pragma unroll
                for (int h = 0; h < 8; ++h) if (h != i1 && acc[h] > l2) { l2 = acc[h]; i2 = h; }
                const float w1 = 1.0f / (1.0f + __builtin_amdgcn_exp2f(1.4426950408889634f * (l2 - l1))), w2 = 1.0f - w1;
                if (F.lane == 0) { tokE[2 * r] = i1; tokE[2 * r + 1] = i2; tokW[2 * r] = w1; tokW[2 * r + 1] = w2; }
                if (F.lane < 16) mycnt += ((F.lane < 8 ? i1 : i2) == (F.lane & 7)) ? 1 : 0;
            }
        }
    }
    if (MODE == 2) {
        if (F.lane < 16 && mycnt) __hip_atomic_fetch_add((unsigned*)a->ws + CW_CNT + F.lane, (unsigned)mycnt, __ATOMIC_RELAXED, __HIP_MEMORY_SCOPE_AGENT);
        int* rt = (int*)(a->ws + WS_ROWTOK);
        for (int i = (F.vcu * NWAVES * 64) + F.tid; i < 2 * RMAX; i += F.G * NWAVES * 64) rt[i] = -1;
    }
}
__device__ __forceinline__ void phase_conv(const Frame& F, ArgsP a, const float* convw  , int layer) {
    if (F.vcu < BATCH * NH) {
        const int b = F.vcu >> 3, h = F.vcu & 7; const float* lf = (const float*)(a->ws + WS_LOGF) + ((size_t)b * SEQ) * 8 + h; float* cb = (float*)(a->ws + WS_CB) + (size_t)F.vcu * SEQ;
        LAS float* wt = (LAS float*)F.lds;
        float v[32]; float run = 0.f;
#pragma unroll
        for (int i = 0; i < 32; ++i) { run += lf[(size_t)(F.tid * 32 + i) * 8]; v[i] = run; }
        float inc = run;
#pragma unroll
        for (int o = 1; o < 64; o <<= 1) { const float t = __int_as_float(__builtin_amdgcn_ds_bpermute(((F.lane - o) & 63) << 2, __float_as_int(inc))); if (F.lane >= o) inc += t; }
        if (F.lane == 63) wt[F.wave] = inc;
        __syncthreads();
        float base = inc - run;
        for (int w = 0; w < F.wave; ++w) base += wt[w];
#pragma unroll
        for (int i = 0; i < 32; ++i) cb[F.tid * 32 + i] = base + v[i];
        __syncthreads();
    }
    bf16* Bz = (bf16*)(a->ws + WS_P6); const bf16* Cb = Bz + (size_t)MTOK * 1024; const bf16* Ub = Bz + (size_t)2 * MTOK * 1024;
    const int gw = F.vcu * NWAVES + F.wave, NGW = F.G * NWAVES;
    { const bf16* Qb = Bz + (size_t)3 * MTOK * 1024; const bf16* Kb = Bz + (size_t)4 * MTOK * 1024; const int RPW = MTOK / NGW, r0 = gw * RPW; float qm = 0.f, km = 0.f, dm = 0.f;
      for (int r = r0; r < r0 + RPW; ++r) {
          const GAS v4u* qp = (const GAS v4u*)(Qb + (size_t)r * 1024) + 2 * F.lane; const GAS v4u* kp = (const GAS v4u*)(Kb + (size_t)r * 1024) + 2 * F.lane;
          const v4u q0 = qp[0], q1 = qp[1], k0 = kp[0], k1 = kp[1];
          const unsigned qq[8] = {q0.x, q0.y, q0.z, q0.w, q1.x, q1.y, q1.z, q1.w}, kk[8] = {k0.x, k0.y, k0.z, k0.w, k1.x, k1.y, k1.z, k1.w}; float sq = 0.f, sk = 0.f, sd = 0.f;
#pragma unroll
          for (int i = 0; i < 8; ++i) { const float a0 = pg8::bf_lo(qq[i]), a1 = pg8::bf_hi(qq[i]), b0 = pg8::bf_lo(kk[i]), b1 = pg8::bf_hi(kk[i]); sq += a0 * a0 + a1 * a1; sk += b0 * b0 + b1 * b1; sd += a0 * b0 + a1 * b1; }
#pragma unroll
          for (int o = 1; o < 8; o <<= 1) { sq += __int_as_float(__builtin_amdgcn_ds_bpermute((F.lane ^ o) << 2, __float_as_int(sq))); sk += __int_as_float(__builtin_amdgcn_ds_bpermute((F.lane ^ o) << 2, __float_as_int(sk)));
                                            sd += __int_as_float(__builtin_amdgcn_ds_bpermute((F.lane ^ o) << 2, __float_as_int(sd))); }
          qm = fmaxf(qm, sq); km = fmaxf(km, sk); dm = fmaxf(dm, 64.f - fox::SCALE * sd); }
      if ((F.lane & 7) == 0) { const int bh = (r0 / SEQ) * 8 + (F.lane >> 3), qb = (r0 % SEQ) >> 8; unsigned* ctl = (unsigned*)a->ws;
          __hip_atomic_fetch_max(ctl + CW_NMAX + layer * 32 + 16 + bh, __float_as_uint(km), __ATOMIC_RELAXED, __HIP_MEMORY_SCOPE_AGENT);
          __hip_atomic_fetch_max(ctl + CW_BQ + layer * 1024 + bh * 64 + qb, __float_as_uint(qm), __ATOMIC_RELAXED, __HIP_MEMORY_SCOPE_AGENT);
          __hip_atomic_fetch_max(ctl + CW_BD + layer * 1024 + bh * 64 + qb, __float_as_uint(dm), __ATOMIC_RELAXED, __HIP_MEMORY_SCOPE_AGENT); } }
    for (int it = gw; it < (MTOK / 32) * 2; it += NGW) {
        const int hf = it & 1, t0 = (it >> 1) * 32, c0 = hf * 512 + F.lane * 8;
        float w0[8], w1[8], w2[8];
#pragma unroll
        for (int i = 0; i < 8; ++i) { w0[i] = convw[c0 + i]; w1[i] = convw[1024 + c0 + i]; w2[i] = convw[2048 + c0 + i]; }
        float p2[8], p1[8];
        const bool first = (t0 % SEQ) == 0;
        { v4u cw = {0u, 0u, 0u, 0u}, uw = cw, cw1 = cw, uw1 = cw;
          if (!first) { cw = *(const GAS v4u*)(Cb + (size_t)(t0 - 2) * 1024 + c0); uw = *(const GAS v4u*)(Ub + (size_t)(t0 - 2) * 1024 + c0);
                        cw1 = *(const GAS v4u*)(Cb + (size_t)(t0 - 1) * 1024 + c0); uw1 = *(const GAS v4u*)(Ub + (size_t)(t0 - 1) * 1024 + c0); }
          const unsigned cc[4] = {cw.x, cw.y, cw.z, cw.w}, uu[4] = {uw.x, uw.y, uw.z, uw.w}, cc1[4] = {cw1.x, cw1.y, cw1.z, cw1.w}, uu1[4] = {uw1.x, uw1.y, uw1.z, uw1.w};
#pragma unroll
          for (int q = 0; q < 4; ++q) { p2[2 * q] = pg8::bf_lo(cc[q]) * pg8::bf_lo(uu[q]); p2[2 * q + 1] = pg8::bf_hi(cc[q]) * pg8::bf_hi(uu[q]);
                                        p1[2 * q] = pg8::bf_lo(cc1[q]) * pg8::bf_lo(uu1[q]); p1[2 * q + 1] = pg8::bf_hi(cc1[q]) * pg8::bf_hi(uu1[q]); } }
#pragma unroll 4
        for (int i = 0; i < 32; ++i) { const size_t o = (size_t)(t0 + i) * 1024 + c0;
            const v4u cw = *(const GAS v4u*)(Cb + o), uw = *(const GAS v4u*)(Ub + o), bw = *(const GAS v4u*)(Bz + o);
            const unsigned cc[4] = {cw.x, cw.y, cw.z, cw.w}, uu[4] = {uw.x, uw.y, uw.z, uw.w}, bq[4] = {bw.x, bw.y, bw.z, bw.w}; float cur[8], z[8];
#pragma unroll
            for (int q = 0; q < 4; ++q) { cur[2 * q] = pg8::bf_lo(cc[q]) * pg8::bf_lo(uu[q]); cur[2 * q + 1] = pg8::bf_hi(cc[q]) * pg8::bf_hi(uu[q]); }
#pragma unroll
            for (int q = 0; q < 4; ++q) { z[2 * q] = pg8::bf_lo(bq[q]) * (w0[2 * q] * p2[2 * q] + w1[2 * q] * p1[2 * q] + w2[2 * q] * cur[2 * q]);
                                          z[2 * q + 1] = pg8::bf_hi(bq[q]) * (w0[2 * q + 1] * p2[2 * q + 1] + w1[2 * q + 1] * p1[2 * q + 1] + w2[2 * q + 1] * cur[2 * q + 1]); }
            v4u ow; ow.x = pk2(z[0], z[1]); ow.y = pk2(z[2], z[3]); ow.z = pk2(z[4], z[5]); ow.w = pk2(z[6], z[7]);
            *(GAS v4u*)(Bz + o) = ow;
#pragma unroll
            for (int q = 0; q < 8; ++q) { p2[q] = p1[q]; p1[q] = cur[q]; } }
    }
}
__device__ __forceinline__ fox::BlockRef<fox::bf16, fox::bf16> fox_ref(ArgsP a, int bh, int qb, int jlo) {
    fox::bf16* P6 = (fox::bf16*)(a->ws + WS_P6); const int b = bh >> 3, h = bh & 7; const size_t base = (size_t)b * SEQ * 1024 + h * 128;
    fox::BlockRef<fox::bf16, fox::bf16> r;
    r.Q = P6 + (size_t)3 * MTOK * 1024 + base + (size_t)qb * 256 * 1024; r.O = (fox::bf16*)r.Q;
    r.K = P6 + (size_t)4 * MTOK * 1024 + base; r.V = P6 + (size_t)5 * MTOK * 1024 + base;
    r.cb = (const float*)(a->ws + WS_CB) + (size_t)bh * SEQ; r.P0 = qb * 256; r.cref = r.cb[r.P0]; r.jlo = jlo;
    return r;
}
__device__ __forceinline__ void phase_attn(const Frame& F, ArgsP a, char* lds, int layer) {
    constexpr int NQB = SEQ / 256, NX = NQB / 2, TOTAL = BATCH * NH * NX;
    LAS int* jl = (LAS int*)(F.lds + JLO_OFF);
    for (int k = 0; k < 4; ++k) {
        const int Lk = F.vcu + (k >> 1) * F.G; int jlo = 0;
        if (Lk < TOTAL) { const int bh = Lk / NX, x = Lk % NX, qb = (k & 1) ? NQB - 1 - x : x, P0 = qb * 256, nt0 = P0 / 64;
            const float* cb = (const float*)(a->ws + WS_CB) + (size_t)bh * SEQ; const unsigned* ctl = (const unsigned*)a->ws;
            const float U = fox::SCALE * sqrtf(__uint_as_float(ctl[CW_BQ + layer * 1024 + bh * 64 + qb]) * __uint_as_float(ctl[CW_NMAX + layer * 32 + 16 + bh])) * 1.001f;
            const float md = __uint_as_float(ctl[CW_BD + layer * 1024 + bh * 64 + qb]) - 64.f + 0.01f;
            const float thr = U + md + PRUNE_T, cref = cb[P0];
            bool keep = false; if (F.tid < nt0) keep = (cref - cb[64 * F.tid + 63]) > -thr;
            const unsigned long long m = __ballot(keep); const int first = m ? F.wave * 64 + (int)__builtin_ctzll(m) : (1 << 20);
            if (F.lane == 0) jl[4 + F.wave] = first;
            __syncthreads();
            jlo = nt0;
#pragma unroll
            for (int w = 0; w < 8; ++w) jlo = min(jlo, jl[4 + w]);
            __syncthreads(); }
        if (F.tid == 0) jl[k] = jlo;
    }
    __syncthreads();
    int L = F.vcu; if (L >= TOTAL) return;
    int pass = 0, it = 0;
    fox::BlockRef<fox::bf16, fox::bf16> cur = fox_ref(a, L / NX, L % NX, jl[0]);
    fox::Seam<fox::bf16> S;
    fox::causal_swa_prime<fox::bf16, fox::bf16>(cur, SEQ, lds, S, F.wave);
    for (;;) {
        const bool more_pass = pass == 0, more_item = L + F.G < TOTAL, last = !more_pass && !more_item;
        int passn = pass + 1, Ln = L, itn = it;
        if (!more_pass) { passn = 0; Ln = more_item ? L + F.G : L; itn = more_item ? it + 1 : it; }
        const int xn = Ln % NX;
        const fox::BlockRef<fox::bf16, fox::bf16> nxt = last ? cur : fox_ref(a, Ln / NX, passn ? NQB - 1 - xn : xn, jl[(2 * itn + passn) & 3]);
        fox::causal_swa_block<fox::bf16, fox::bf16>(cur, nxt, SEQ, SEQ, lds, S, F.wave);
        if (last) break;
        cur = nxt; pass = passn; L = Ln; it = itn;
    }
}
struct MoeLayout { int base[8]; int ntiles; };
__device__ __forceinline__ void moe_layout(ArgsP a, int rank, MoeLayout& ml) {
    const unsigned* cnt = (const unsigned*)a->ws + CW_CNT + rank * 8; int run = 0;
#pragma unroll
    for (int e = 0; e < 8; ++e) { ml.base[e] = run; run += ((int)cnt[e] + 255) & ~255; }
    ml.ntiles = run >> 8;
}
__device__ __forceinline__ void moe_tile_table(const Frame& F, ArgsP a, int rank, int& ntiles) {
    MoeLayout ml; moe_layout(a, rank, ml); ntiles = ml.ntiles;
    LAS int* te = (LAS int*)(F.lds + TILE_E_OFF);
    for (int t = F.tid; t < 160; t += NWAVES * 64) { int e = 0;
#pragma unroll
        for (int q = 1; q < 8; ++q) e += (t * 256 >= ml.base[q]) ? 1 : 0;
        te[t] = e; }
    __syncthreads();
}
__device__ __forceinline__ void gather_row(const bf16* src, unsigned char* dst, int lane) {
    const GAS v4u* s = (const GAS v4u*)src + 2 * lane; GAS v4u* d = (GAS v4u*)dst + lane;
    const v4u a0 = s[0], a1 = s[1], b0 = s[128], b1 = s[129];
#define G8(p, q) pg8::pk4_fp8(pg8::bf_lo(p) * pg8::F8_XS, pg8::bf_hi(p) * pg8::F8_XS, pg8::bf_lo(q) * pg8::F8_XS, pg8::bf_hi(q) * pg8::F8_XS)
    v4u o0, o1; o0.x = G8(a0.x, a0.y); o0.y = G8(a0.z, a0.w); o0.z = G8(a1.x, a1.y); o0.w = G8(a1.z, a1.w);
    o1.x = G8(b0.x, b0.y); o1.y = G8(b0.z, b0.w); o1.z = G8(b1.x, b1.y); o1.w = G8(b1.z, b1.w);
#undef G8
    d[0] = o0; d[64] = o1;
}
__device__ __forceinline__ void phase_route(const Frame& F, ArgsP a) {
    MoeLayout ml0, ml1; moe_layout(a, 0, ml0); moe_layout(a, 1, ml1);
    const int* tokE = (const int*)(a->ws + WS_TOKE); const float* tokW = (const float*)(a->ws + WS_TOKW);
    int* rowtok = (int*)(a->ws + WS_ROWTOK); float* roww = (float*)(a->ws + WS_ROWW); unsigned* cur = (unsigned*)a->ws + CW_CUR;
    const bf16* A2 = (const bf16*)(a->ws + WS_A); unsigned char* XG = (unsigned char*)(a->ws + WS_XG);
    const int gw = F.vcu * NWAVES + F.wave, NGW = F.G * NWAVES;
    for (int t0 = gw * 16; t0 < MTOK; t0 += NGW * 16) {
        const bool act = F.lane < 16; const int t = t0 + (F.lane & 15);
        int pos0 = 0;
#pragma unroll
        for (int rank = 0; rank < 2; ++rank) {
            const int e = act ? tokE[2 * t + rank] : -1; const float w = act ? tokW[2 * t + rank] : 0.f; int pos = -1;
#pragma unroll
            for (int q = 0; q < 8; ++q) { const unsigned long long m = __ballot(e == q);
                if (m) { unsigned b0 = 0; if (F.lane == 0) b0 = __hip_atomic_fetch_add(cur + rank * 8 + q, (unsigned)__popcll(m), __ATOMIC_RELAXED, __HIP_MEMORY_SCOPE_AGENT);
                    b0 = __builtin_amdgcn_readfirstlane(b0);
                    if (e == q) pos = (rank ? ml1.base[q] : ml0.base[q]) + (int)b0 + __popcll(m & ((1ull << F.lane) - 1ull)); } }
            if (act) { rowtok[rank * RMAX + pos] = t; roww[rank * RMAX + pos] = w; }
            if (rank == 0) pos0 = pos;
        }
        for (int i = 0; i < 16; ++i) { const int p = __builtin_amdgcn_readlane(pos0, i); gather_row(A2 + (size_t)(t0 + i) * DM, XG + (size_t)p * DM, F.lane); }
    }
}
__device__ __forceinline__ void phase_gather(const Frame& F, ArgsP a, int rank) {
    MoeLayout ml; moe_layout(a, rank, ml);
    const int* rowtok = (const int*)(a->ws + WS_ROWTOK) + rank * RMAX; const bf16* A2 = (const bf16*)(a->ws + WS_A); unsigned char* XG = (unsigned char*)(a->ws + WS_XG);
    const int gw = F.vcu * NWAVES + F.wave, NGW = F.G * NWAVES, nrows = ml.ntiles * 256;
    for (int p = gw; p < nrows; p += NGW) { const int t = rowtok[p]; if (t >= 0) gather_row(A2 + (size_t)t * DM, XG + (size_t)p * DM, F.lane); }
}

__global__ void __launch_bounds__(NWAVES * 64, 2) fwd(Args args) {
    extern __shared__ __attribute__((aligned(16))) unsigned char lds_raw[];
    { const int t0 = threadIdx.x; for (int u = t0; u < (LDS_BYTES - LDSCTL_OFF) / 4; u += NWAVES * 64) ((LAS unsigned*)((LAS unsigned char*)lds_raw + LDSCTL_OFF))[u] = 0u; }
    __syncthreads();
    (void)xcd_barrier_post((unsigned*)args.ws + CW_BAR, (volatile LAS unsigned*)((LAS unsigned char*)lds_raw + MISC_OFF) + 8);
    const int lo = args.ph_lo, hi = args.ph_hi; int ph = 0;
    const int wave0 = __builtin_amdgcn_readfirstlane((int)threadIdx.x >> 6);
#define FORCE_SEAM() do { XcdBarrier b3; b3.bar = (unsigned*)args.ws + CW_BAR; b3.x = xb_xcc_id(); b3.st = (volatile LAS unsigned*)((LAS unsigned char*)lds_raw + MISC_OFF) + 8; xcd_barrier(b3); } while (0)
#define PH_ON (ph >= lo && ph < hi)
#define PH_SEAM() do { if (ph + 1 < hi) { XcdBarrier b2; b2.bar = (unsigned*)ws + CW_BAR; b2.x = xb_xcc_id(); b2.st = (volatile LAS unsigned*)((LAS unsigned char*)lds_raw + MISC_OFF) + 8; xcd_barrier(b2); } } while (0)
#define PH_FRAME() Frame F; F.lds = (LAS unsigned char*)lds_raw; F.tid = pg8::opaque_tid(wave0); F.lane = F.tid & 63; F.wave = __builtin_amdgcn_readfirstlane(F.tid >> 6); \
    F.G = gridDim.x; { const int bx = blockIdx.x; F.vcu = (F.G % 8 == 0) ? (bx % 8) * (F.G / 8) + bx / 8 : bx; } \
    ArgsP A = (ArgsP)__builtin_amdgcn_kernarg_segment_ptr(); asm volatile("" : "+s"(A)); unsigned char* ws = A->ws; float* const out = A->out; (void)out; \
    bf16* const A_ = (bf16*)(ws + WS_A); bf16* const P6_ = (bf16*)(ws + WS_P6); bf16* const G_ = (bf16*)(ws + WS_G); (void)A_; (void)P6_; (void)G_

    if (PH_ON) {  PH_FRAME(); phase_convert(F, A);  PH_SEAM(); } ++ph;

    for (int layer = 0; layer < 2; ++layer) {

        if (PH_ON) {  PH_FRAME(); phase_norm<0>(F, A, layer == 0 ? A->in[I_X] : (const float*)out, A->in[I_MIXN] + layer * DM, A_, nullptr, A->in[I_WIN] + (size_t)layer * DM * PTOT + 6144, PTOT, A->in[I_BF] + layer * 8);  PH_SEAM(); } ++ph;
        if (PH_ON) {  PH_FRAME(); pg8::Gemm g{A_, (const bf16*)(ws + WS_WIN) + (size_t)layer * NPROJ * DM, MTOK, NPROJ, DM}; pg8::StaticOrder S; S.init(MTOK, NPROJ, F.G, (int)blockIdx.x);
            pg8::EpiInProj E{P6_, G_, MTOK};
            pg8::gemm_phase<pg8::EpiInProj, pg8::StaticOrder, true, true>(F.lds, g, S, E, F.tid);  PH_SEAM(); } ++ph;
        if (PH_ON) { PH_FRAME(); phase_conv(F, A, A->in[I_CONVW] + layer * 3 * DCONV, layer); PH_SEAM(); } ++ph;
        if (PH_ON) { { PH_FRAME(); phase_attn(F, A, (char*)lds_raw, layer); }
             PH_FRAME(); pg8::Gemm g{P6_, (const bf16*)(ws + WS_WCO) + (size_t)layer * DM * 1024, MTOK, DM, 1024}; pg8::StaticOrder S; S.init(MTOK, DM, F.G, (int)blockIdx.x);
            pg8::EpiMerge<0> E{G_, A_};
            pg8::gemm_phase<pg8::EpiMerge<0>, pg8::StaticOrder, true, true>(F.lds, g, S, E, F.tid);  PH_SEAM(); } ++ph;
        if (PH_ON) { PH_FRAME(); pg8::Gemm g{P6_ + (size_t)3 * MTOK * 1024, (const bf16*)(ws + WS_WAO) + (size_t)layer * DM * 1024, MTOK, DM, 1024}; pg8::StaticOrder S; S.init(MTOK, DM, F.G, (int)blockIdx.x);
            pg8::EpiMerge<1> E{G_ + 2048, A_};
            pg8::gemm_phase<pg8::EpiMerge<1>, pg8::StaticOrder, true, true>(F.lds, g, S, E, F.tid); PH_SEAM(); } ++ph;
        if (PH_ON) {  PH_FRAME(); pg8::Gemm g{A_, (const bf16*)(ws + WS_WO) + (size_t)layer * DM * DM, MTOK, DM, DM}; pg8::StaticOrder S; S.init(MTOK, DM, F.G, (int)blockIdx.x);
            pg8::EpiResid E{layer == 0 ? A->in[I_X] : (const float*)out, out};
            pg8::gemm_phase<pg8::EpiResid, pg8::StaticOrder, true, true>(F.lds, g, S, E, F.tid);  PH_SEAM(); } ++ph;
        if (layer == 0) {
            if (PH_ON) {  PH_FRAME(); phase_norm<1>(F, A, out, A->in[I_FFNN], A_, nullptr, nullptr, 0, nullptr);  PH_SEAM(); } ++ph;
            if (PH_ON) {  PH_FRAME(); pg8::Gemm g{A_, (const bf16*)(ws + WS_WGU), MTOK, 2 * DFF, DM}; pg8::StaticOrder S; S.init(MTOK, 2 * DFF, F.G, (int)blockIdx.x);
                pg8::EpiSwiGLU E{(bf16*)(ws + WS_HID), DFF};
                pg8::gemm_phase<pg8::EpiSwiGLU, pg8::StaticOrder, true, true>(F.lds, g, S, E, F.tid);  PH_SEAM(); } ++ph;
            if (PH_ON) { PH_FRAME(); pg8::Gemm g{(const bf16*)(ws + WS_HID), (const bf16*)(ws + WS_WDD), MTOK, DM, DFF}; pg8::StaticOrder S; S.init(MTOK, DM, F.G, (int)blockIdx.x);
                pg8::EpiResid E{out, out};
                pg8::gemm_phase<pg8::EpiResid, pg8::StaticOrder, true, true>(F.lds, g, S, E, F.tid); PH_SEAM(); } ++ph;
        } else {
            if (PH_ON) { PH_FRAME(); phase_norm<2>(F, A, out, A->in[I_FFNN] + DM, A_, nullptr, A->in[I_RW], 8, A->in[I_RB]); PH_SEAM(); } ++ph;
            if (PH_ON) { PH_FRAME(); phase_route(F, A); PH_SEAM(); } ++ph;
            for (int rank = 0; rank < 2; ++rank) {
                if (rank == 1) { if (PH_ON) {  PH_FRAME(); phase_gather(F, A, 1);  PH_SEAM(); } ++ph; }
                if (PH_ON) {  PH_FRAME(); int nt; moe_tile_table(F, A, rank, nt);
                    pg8::Gemm g{(const bf16*)(ws + WS_XG), (const bf16*)(ws + WS_MWGU), nt * 256, 2 * DFFE, DM}; pg8::MoeOrder S; S.init(nt * 256, 2 * DFFE, F.G, (int)blockIdx.x);
                    S.tile_e = (const LAS int*)(F.lds + TILE_E_OFF); S.estride = (size_t)2 * DFFE * DM;
                    pg8::EpiSwiGLU8 E{(unsigned char*)(ws + WS_HID), DFFE};
                    pg8::gemm_phase<pg8::EpiSwiGLU8, pg8::MoeOrder, true, true, true>(F.lds, g, S, E, F.tid);  PH_SEAM(); } ++ph;
                if (PH_ON) { PH_FRAME(); int nt; moe_tile_table(F, A, rank, nt);
                    pg8::Gemm g{(const bf16*)(ws + WS_HID), (const bf16*)(ws + WS_MWD), nt * 256, DM, DFFE}; pg8::MoeOrder S; S.init(nt * 256, DM, F.G, (int)blockIdx.x);
                    S.tile_e = (const LAS int*)(F.lds + TILE_E_OFF); S.estride = (size_t)DM * DFFE;
                    pg8::EpiMoeDown E{(const int*)(ws + WS_ROWTOK) + rank * RMAX, (const float*)(ws + WS_ROWW) + rank * RMAX, out, 1.0f / (pg8::F8_HS * pg8::F8_WS)};
                    pg8::gemm_phase<pg8::EpiMoeDown, pg8::MoeOrder, true, true, true>(F.lds, g, S, E, F.tid); PH_SEAM(); } ++ph;
            }
        }
    }
    if (PH_ON) { PH_FRAME(); phase_norm<3>(F, A, out, A->in[I_FN], nullptr, out, nullptr, 0, nullptr); } ++ph;
#undef PH_ON
#undef PH_SEAM
#undef PH_FRAME
}
constexpr int N_PHASES = 1 + 6 + 3 + 6 + 2 + 1 + 2 * 2 + 1;

extern "C" void kernel_launch(void* const* d_in, const int* in_sizes, int n_in, void* d_out, int out_size, void* d_ws, size_t ws_size, hipStream_t stream) {
    static int grid = 0;
    if (grid == 0) {
        if (n_in != N_IN || in_sizes[0] != MTOK * DM || out_size != MTOK * DM || ws_size < WS_END) { fprintf(stderr, "kernel_launch: shape/workspace mismatch (n_in %d, ws %zu, need %zu); nothing launched\n", n_in, ws_size, (size_t)WS_END); grid = -1; return; }
        int dev = 0, cus = 0, per_cu = 0;
        if (hipGetDevice(&dev) != hipSuccess || hipDeviceGetAttribute(&cus, hipDeviceAttributeMultiprocessorCount, dev) != hipSuccess) { grid = -1; return; }
        if (hipFuncSetAttribute((const void*)fwd, hipFuncAttributeMaxDynamicSharedMemorySize, LDS_BYTES) != hipSuccess) { fprintf(stderr, "kernel_launch: hipFuncSetAttribute failed\n"); grid = -1; return; }
        if (hipOccupancyMaxActiveBlocksPerMultiprocessor(&per_cu, (const void*)fwd, NWAVES * 64, LDS_BYTES) != hipSuccess || per_cu < 1) { fprintf(stderr, "kernel_launch: occupancy query says %d\n", per_cu); grid = -1; (void)hipGetLastError(); return; }
        grid = cus;
        if (MTOK % (grid * NWAVES) != 0) { fprintf(stderr, "kernel_launch: grid %d does not divide the token rows\n", grid); grid = -1; return; }
    }
    if (grid < 0) return;
    if (hipMemsetAsync((char*)d_ws + WS_CTL, 0, CTL_ZERO_BYTES, stream) != hipSuccess) return;
    Args ka; memset(&ka, 0, sizeof(ka));
    for (int i = 0; i < N_IN; ++i) ka.in[i] = (const float*)d_in[i];
    ka.out = (float*)d_out; ka.ws = (unsigned char*)d_ws;
#if MK_PER_PHASE
    for (int p = 0; p < N_PHASES; ++p) { ka.ph_lo = p; ka.ph_hi = p + 1; hipLaunchKernelGGL(fwd, dim3(grid), dim3(NWAVES * 64), LDS_BYTES, stream, ka); }
#else
    ka.ph_lo = 0; ka.ph_hi = N_PHASES; hipLaunchKernelGGL(fwd, dim3(grid), dim3(NWAVES * 64), LDS_BYTES, stream, ka);
#endif
}
```
